# Optimizing an MI355X kernel written in HIP

```python
import jax, jax.numpy as jnp
from jax import lax
import numpy as np

D_MODEL = 1024
BATCH = 8
SEQ = 8192
DEPTH = 2

D_MIX = D_MODEL
D_A = D_MIX // 4
D_B = D_MIX // 4
D_C = D_MIX // 2
A_HEADS = 4
A_HEAD_DIM = D_A // A_HEADS
SGU_CHUNK = 128
CONV_WIDTH = 31
C_HEADS = 4
C_HEAD_DIM = D_C // C_HEADS
HGRN_CHUNK = 64
LN_EPS = 1e-5
DEEPNORM_ALPHA = (2 * DEPTH) ** 0.25
DEEPNORM_BETA = (8 * DEPTH) ** -0.25
SPLIT_SIZES = (D_A, D_A, D_A, D_B, D_B, D_B, D_C, D_C, D_C, D_C)
D_IN = 3 * D_A + 3 * D_B + 4 * D_C

kernel_name = "hybrid_sgu_conformer_hgrn2_deepnorm"


def _layernorm(x, g, b):
    xf = x.astype(jnp.float32)
    mu = jnp.mean(xf, axis=-1, keepdims=True)
    var = jnp.mean(jnp.square(xf - mu), axis=-1, keepdims=True)
    return ((xf - mu) * lax.rsqrt(var + LN_EPS)).astype(x.dtype) * g + b


def _sgu_mixer(u, v, ln_g, ln_b, w_s, b_s):
    u = jax.nn.gelu(u)
    v = _layernorm(jax.nn.gelu(v), ln_g, ln_b)
    bsz, seq, _ = v.shape
    n_chunks = seq // SGU_CHUNK
    vc = v.reshape(bsz, n_chunks, SGU_CHUNK, A_HEADS, A_HEAD_DIM)
    causal = jnp.tril(jnp.ones((SGU_CHUNK, SGU_CHUNK), dtype=bool))
    w = jnp.where(causal[None], w_s, 0)
    mixed = jnp.einsum('hts,bnshd->bnthd', w, vc) + b_s.T[None, None, :, :, None]
    return u * mixed.reshape(bsz, seq, D_A)


def _conv_module(val, glu_gate, w_dw, b_dw, ln_g, ln_b):
    h = val * jax.nn.sigmoid(glu_gate)
    h = lax.conv_general_dilated(
        h, w_dw[:, None, :], window_strides=(1,),
        padding=[(CONV_WIDTH - 1, 0)],
        dimension_numbers=('NWC', 'WIO', 'NWC'),
        feature_group_count=D_B) + b_dw
    h = _layernorm(h, ln_g, ln_b)
    return jax.nn.silu(h)


def _hgrn2_mixer(q, f_logit, i, lb, norm_g):
    bsz, seq, _ = q.shape
    out_dtype = q.dtype
    f = lb + (1.0 - lb) * jax.nn.sigmoid(f_logit.astype(jnp.float32))
    log_f = jnp.log(f)
    k = 1.0 - f
    qf = jax.nn.silu(q.astype(jnp.float32))
    vf = i.astype(jnp.float32)
    n_chunks = seq // HGRN_CHUNK

    def to_chunks(t):
        return t.reshape(bsz, n_chunks, HGRN_CHUNK, C_HEADS, C_HEAD_DIM).transpose(1, 0, 3, 2, 4)

    causal = jnp.tril(jnp.ones((HGRN_CHUNK, HGRN_CHUNK), dtype=bool))

    def step(state, inp):
        qc, kc, vc, gc = inp
        b = jnp.cumsum(gc, axis=2)
        diff = b[:, :, :, None, :] - b[:, :, None, :, :]
        decay = jnp.exp(jnp.where(causal[None, None, :, :, None], diff, -jnp.inf))
        scores = jnp.einsum('bhtd,bhsd,bhtsd->bhts', qc, kc, decay)
        o_intra = jnp.einsum('bhts,bhsv->bhtv', scores, vc)
        o_inter = jnp.einsum('bhtd,bhdv->bhtv', qc * jnp.exp(b), state)
        b_last = b[:, :, -1:, :]
        new_state = (jnp.exp(b_last[:, :, 0, :])[..., None] * state
                     + jnp.einsum('bhsd,bhsv->bhdv', kc * jnp.exp(b_last - b), vc))
        return new_state, o_intra + o_inter

    state0 = jnp.zeros((bsz, C_HEADS, C_HEAD_DIM, C_HEAD_DIM), jnp.float32)
    _, o = lax.scan(step, state0, (to_chunks(qf), to_chunks(k), to_chunks(vf), to_chunks(log_f)))
    o = o.transpose(1, 0, 3, 2, 4).reshape(bsz, seq, C_HEADS, C_HEAD_DIM)
    o = o * lax.rsqrt(jnp.mean(jnp.square(o), axis=-1, keepdims=True) + LN_EPS)
    return o.reshape(bsz, seq, D_C).astype(out_dtype) * norm_g


def _hybrid_layer(x, w_in, sgu_ln_g, sgu_ln_b, sgu_w, sgu_b, conv_w, conv_b,
                  conv_ln_g, conv_ln_b, lb, hgrn_norm_g, w_out, post_ln_g, post_ln_b):
    h = jnp.einsum('bsd,de->bse', x, w_in)
    offsets = np.cumsum(SPLIT_SIZES)[:-1].tolist()
    a_u, a_v, a_g, b_val, b_glu, b_g, c_q, c_f, c_i, c_g = jnp.split(h, offsets, axis=-1)
    y_a = _sgu_mixer(a_u, a_v, sgu_ln_g, sgu_ln_b, sgu_w, sgu_b) * jax.nn.silu(a_g)
    y_b = _conv_module(b_val, b_glu, conv_w, conv_b, conv_ln_g, conv_ln_b) * jax.nn.silu(b_g)
    y_c = _hgrn2_mixer(c_q, c_f, c_i, lb, hgrn_norm_g) * jax.nn.silu(c_g)
    y = jnp.concatenate([y_a, y_b, y_c], axis=-1)
    y = jnp.einsum('bse,ed->bsd', y, w_out)
    return _layernorm(DEEPNORM_ALPHA * x + y, post_ln_g, post_ln_b)


def setup_inputs(seed: int = 0) -> dict:
    key = jax.random.key(seed)
    ks = jax.random.split(key, 16)
    f32 = jnp.float32
    nrm = lambda k, shape, s: jax.random.normal(k, shape, f32) * s
    x = jax.random.normal(ks[0], (BATCH, SEQ, D_MODEL), f32)
    w_in = nrm(ks[1], (DEPTH, D_MODEL, D_IN), D_MODEL ** -0.5)
    sgu_ln_g = 1.0 + nrm(ks[2], (DEPTH, D_A), 0.02)
    sgu_ln_b = nrm(ks[3], (DEPTH, D_A), 0.02)
    sgu_w = nrm(ks[4], (DEPTH, A_HEADS, SGU_CHUNK, SGU_CHUNK), 0.5 * SGU_CHUNK ** -0.5)
    sgu_b = 1.0 + nrm(ks[5], (DEPTH, A_HEADS, SGU_CHUNK), 0.02)
    conv_w = nrm(ks[6], (DEPTH, CONV_WIDTH, D_B), CONV_WIDTH ** -0.5)
    conv_b = nrm(ks[7], (DEPTH, D_B), 0.01)
    conv_ln_g = 1.0 + nrm(ks[8], (DEPTH, D_B), 0.02)
    conv_ln_b = nrm(ks[9], (DEPTH, D_B), 0.02)
    hgrn_lb = nrm(ks[10], (DEPTH, D_C), 0.1)
    hgrn_norm_g = 1.0 + nrm(ks[11], (DEPTH, D_C), 0.02)
    w_out = nrm(ks[12], (DEPTH, D_MIX, D_MODEL), DEEPNORM_BETA * D_MIX ** -0.5)
    post_ln_g = 1.0 + nrm(ks[13], (DEPTH, D_MODEL), 0.02)
    post_ln_b = nrm(ks[14], (DEPTH, D_MODEL), 0.02)
    return {"x": x, "w_in": w_in, "sgu_ln_g": sgu_ln_g, "sgu_ln_b": sgu_ln_b,
            "sgu_w": sgu_w, "sgu_b": sgu_b, "conv_w": conv_w, "conv_b": conv_b,
            "conv_ln_g": conv_ln_g, "conv_ln_b": conv_ln_b, "hgrn_lb": hgrn_lb,
            "hgrn_norm_g": hgrn_norm_g, "w_out": w_out, "post_ln_g": post_ln_g,
            "post_ln_b": post_ln_b}


def reference(x, w_in, sgu_ln_g, sgu_ln_b, sgu_w, sgu_b, conv_w, conv_b, conv_ln_g,
              conv_ln_b, hgrn_lb, hgrn_norm_g, w_out, post_ln_g, post_ln_b):
    gamma = jax.nn.softmax(hgrn_lb.astype(jnp.float32), axis=0)
    lower_bounds = jnp.cumsum(gamma, axis=0) - gamma[0:1]
    for l in range(DEPTH):
        x = _hybrid_layer(x, w_in[l], sgu_ln_g[l], sgu_ln_b[l], sgu_w[l], sgu_b[l],
                          conv_w[l], conv_b[l], conv_ln_g[l], conv_ln_b[l],
                          lower_bounds[l], hgrn_norm_g[l], w_out[l], post_ln_g[l], post_ln_b[l])
    return x
```

```cpp
#include <hip/hip_runtime.h>
#include <hip/hip_cooperative_groups.h>
#include <cstdio>
namespace cg = cooperative_groups;

#define LAS __attribute__((address_space(3)))
typedef unsigned short bf16_t;
typedef short bf16x8 __attribute__((ext_vector_type(8)));
typedef float f32x4 __attribute__((ext_vector_type(4)));
typedef unsigned u32x4 __attribute__((ext_vector_type(4)));
typedef unsigned u32x2 __attribute__((ext_vector_type(2)));

constexpr int MTOK = 65536, DM = 1024, DIN = 3584, SEQ = 8192, NB = 8;
constexpr int OFF_AU = 0, OFF_AV = 256, OFF_AG = 512, OFF_BV = 768, OFF_BGLU = 1024, OFF_BG = 1280, OFF_CQ = 1536, OFF_CF = 2048, OFF_CI = 2560, OFF_CG = 3072;
constexpr float LN_EPS = 1e-5f;
constexpr float ALPHA = 1.41421356237309515f;
constexpr int NTHR = 512;
constexpr int LDS_BYTES = 131072;

constexpr size_t WS_WTIN = 0;
constexpr size_t WS_WTOUT = WS_WTIN + 2ull * 3584 * 1024 * 2;
constexpr size_t WS_WSB = WS_WTOUT + 2ull * 1024 * 1024 * 2;
constexpr size_t WS_DEC = WS_WSB + 2ull * 4 * 128 * 128 * 2;
constexpr size_t WS_XB = WS_DEC + 4096ull * 128 * 4;
constexpr size_t WS_Y = WS_XB + (size_t)MTOK * DM * 2;
constexpr size_t WS_ST = WS_Y + (size_t)MTOK * DM * 2;
constexpr size_t WS_H = WS_ST + 4096ull * 16384 * 2;
constexpr size_t WS_Z = WS_H;
constexpr size_t WS_END = WS_H + (size_t)MTOK * DIN * 2;

struct Params {
    const float* x; const float* w_in; const float* sgu_ln_g; const float* sgu_ln_b; const float* sgu_w; const float* sgu_b;
    const float* conv_w; const float* conv_b; const float* conv_ln_g; const float* conv_ln_b; const float* hgrn_lb; const float* hgrn_norm_g;
    const float* w_out; const float* post_ln_g; const float* post_ln_b;
    float* out; unsigned char* ws;
    int ph_lo, ph_hi;
};

__device__ __forceinline__ unsigned cvt_pk_bf16(float lo, float hi) { unsigned r; asm volatile("v_cvt_pk_bf16_f32 %0, %1, %2" : "=v"(r) : "v"(lo), "v"(hi)); return r; }
__device__ __forceinline__ float bflo(unsigned u) { return __uint_as_float(u << 16); }
__device__ __forceinline__ float bfhi(unsigned u) { return __uint_as_float(u & 0xffff0000u); }
__device__ __forceinline__ float bf2f(bf16_t b) { return __uint_as_float(((unsigned)b) << 16); }
__device__ __forceinline__ float fexp(float x) { return __builtin_amdgcn_exp2f(x * 1.44269504088896341f); }
__device__ __forceinline__ float frcp(float x) { return __builtin_amdgcn_rcpf(x); }
__device__ __forceinline__ float sigmoidf_(float x) { return frcp(1.0f + fexp(-x)); }
__device__ __forceinline__ float siluf_(float x) { return x * sigmoidf_(x); }
__device__ __forceinline__ float gelu_tanh(float x) { const float y = 1.5957691216057308f * (x + 0.044715f * x * x * x); return x * sigmoidf_(y); }
__device__ __forceinline__ void unpack8(const u32x4 v, float (&f)[8]) {
    f[0] = bflo(v.x); f[1] = bfhi(v.x); f[2] = bflo(v.y); f[3] = bfhi(v.y); f[4] = bflo(v.z); f[5] = bfhi(v.z); f[6] = bflo(v.w); f[7] = bfhi(v.w);
}
__device__ __forceinline__ u32x4 pack8(const float (&f)[8]) {
    u32x4 r; r.x = cvt_pk_bf16(f[0], f[1]); r.y = cvt_pk_bf16(f[2], f[3]); r.z = cvt_pk_bf16(f[4], f[5]); r.w = cvt_pk_bf16(f[6], f[7]); return r;
}
__device__ __forceinline__ int opaque_tid() { int t = threadIdx.x; asm volatile("" : "+v"(t)); return t; }
__device__ __forceinline__ float xor_sum8(float v) {
    v += __shfl_xor(v, 1); v += __shfl_xor(v, 2); v += __shfl_xor(v, 4); return v;
}

namespace pg8 {
constexpr int BM = 256, BK = 64, HALF = 128, HTB = HALF * BK * 2, STAGE_BYTES = 8 * HTB, NXCD = 8, WGM = 8;
__host__ __device__ __forceinline__ int lds_byte(int r, int c) { const int st = (r >> 4) * 2 + (c >> 5), rr = r & 15, cc = c & 31, ob = rr * 64 + cc * 2; return st * 1024 + (ob ^ (((ob >> 9) & 1) << 5)); }
__host__ __device__ __forceinline__ void stage_rc(int b, int& R, int& C) { const int st = b / 1024, sb = b % 1024, swz = sb ^ (((sb >> 9) & 1) << 5); R = (st >> 1) * 16 + swz / 64; C = (st & 1) * 32 + (swz % 64) / 2; }
__host__ __device__ __forceinline__ int perm32(int rho) { const int n = rho >> 4, i = rho & 15; return 8 * (i >> 2) + 4 * n + (i & 3); }
struct Unit { int pm, pn; };
struct Gemm { const bf16_t* A; const bf16_t* Bt; int M, N, K; };
struct StaticOrder {
    int nM, nN, nwg, G, c;
    __host__ __device__ void init(int M, int N, int G_, int c_) { nM = M / BM; nN = N / BM; nwg = nM * nN; G = G_; c = c_; }
    __host__ __device__ bool next(int i, Unit& u) const {
        const long L = (long)i * G + c; if (L >= nwg) return false;
        int wgid = (int)L; { const int q = nwg / NXCD, r = nwg % NXCD, xcd = wgid % NXCD, off = wgid / NXCD; wgid = (xcd < r ? xcd * (q + 1) : r * (q + 1) + (xcd - r) * q) + off; }
        const int nig = WGM * nN, gid = wgid / nig, fm = gid * WGM, gsz = (nM - fm) < WGM ? (nM - fm) : WGM;
        u.pm = fm + ((wgid % nig) % gsz); u.pn = (wgid % nig) / gsz; return true;
    }
    __device__ __forceinline__ void a_ready(const Unit&) const {}
    __device__ __forceinline__ void done(const Unit&) const {}
};
struct EpiH {
    static constexpr bool PERM = true;
    bf16_t* O; int ldc;
    __device__ __forceinline__ void operator()(const f32x4 (&acc)[2][2][4][2], const Unit& u, int wr, int wc, int fr, int fq) const {
        const int row0 = u.pm * BM + wr * 64 + fr; const int col0 = u.pn * BM + wc * 32 + 8 * fq;
#pragma unroll
        for (int ai = 0; ai < 2; ++ai)
#pragma unroll
            for (int m = 0; m < 4; ++m) { bf16_t* rowp = O + (size_t)(row0 + ai * HALF + m * 16) * ldc + col0;
#pragma unroll
                for (int bj = 0; bj < 2; ++bj) { const f32x4 v0 = acc[ai][bj][m][0], v1 = acc[ai][bj][m][1];
                    u32x4 w; w.x = cvt_pk_bf16(v0[0], v0[1]); w.y = cvt_pk_bf16(v0[2], v0[3]); w.z = cvt_pk_bf16(v1[0], v1[1]); w.w = cvt_pk_bf16(v1[2], v1[3]);
                    *(u32x4*)(rowp + bj * HALF) = w; } }
    }
};
struct EpiZ {
    static constexpr bool PERM = false;
    float* C; const float* R; int ldc;
    __device__ __forceinline__ void operator()(const f32x4 (&acc)[2][2][4][2], const Unit& u, int wr, int wc, int fr, int fq) const {
        const int row0 = u.pm * BM + wr * 64 + fr, col0 = u.pn * BM + wc * 32 + 4 * fq;
#pragma unroll
        for (int ai = 0; ai < 2; ++ai)
#pragma unroll
            for (int m = 0; m < 4; ++m) { const size_t ro = (size_t)(row0 + ai * HALF + m * 16) * ldc + col0;
#pragma unroll
                for (int bj = 0; bj < 2; ++bj)
#pragma unroll
                    for (int n = 0; n < 2; ++n) { const f32x4 r = *(const f32x4*)(R + ro + bj * HALF + n * 16);
                        *(f32x4*)(C + ro + bj * HALF + n * 16) = acc[ai][bj][m][n] + r * ALPHA; } }
    }
};

template <class Epi, class Sched>
__device__ __forceinline__ void gemm_phase(LAS unsigned char* lds, const Gemm g, const Sched& S, const Epi& E) {
    const int tid = opaque_tid(), wid = __builtin_amdgcn_readfirstlane(tid >> 6), lane = tid & 63, wr = wid >> 2, wc = wid & 3, fr = lane & 15, fq = lane >> 4;
    const int K = g.K, nt = K / BK;
    unsigned voffA[2], voffB[2];
#pragma unroll
    for (int i = 0; i < 2; ++i) { int R, C; stage_rc(tid * 16 + i * 8192, R, C); const int Rb = Epi::PERM ? ((R & ~31) + perm32(R & 31)) : R;
        voffA[i] = (unsigned)(R * K + C) * 2u; voffB[i] = (unsigned)(Rb * K + C) * 2u; }
    const size_t kstep = (size_t)(BK * 2);
    const size_t hstep = (size_t)HALF * K * 2;
    const size_t tstep = 2 * hstep;
    const unsigned ldsw = (unsigned)wid * 1024u;
    const int aoff = lds_byte(wr * 64 + fr, fq * 8), boff = lds_byte(wc * 32 + fr, fq * 8);
#define PG8_SA(b, h) (((b) * 2 + (h)) * HTB)
#define PG8_SB(b, h) ((4 + (b) * 2 + (h)) * HTB)
#define PG8_STAGE(bufoff, gbase, voff) do { _Pragma("unroll") for (int _i = 0; _i < 2; ++_i) \
        __builtin_amdgcn_global_load_lds((const unsigned*)((const char*)(gbase) + (voff)[_i]), (LAS unsigned*)(lds + (bufoff) + ldsw + _i * 8192), 16, 0, 0); } while (0)
#define PG8_LDA(dst, b, h) do { _Pragma("unroll") for (int m = 0; m < 4; ++m) _Pragma("unroll") for (int k = 0; k < 2; ++k) dst[m][k] = *(const LAS bf16x8*)(lds + PG8_SA(b, h) + aoff + m * 2048 + k * 1024); } while (0)
#define PG8_LDB(dst, b, h) do { _Pragma("unroll") for (int n = 0; n < 2; ++n) _Pragma("unroll") for (int k = 0; k < 2; ++k) dst[n][k] = *(const LAS bf16x8*)(lds + PG8_SB(b, h) + boff + n * 2048 + k * 1024); } while (0)
#define PG8_MMA(ai, bj, At, Bt) do { __builtin_amdgcn_s_setprio(1); _Pragma("unroll") for (int m = 0; m < 4; ++m) _Pragma("unroll") for (int n = 0; n < 2; ++n) _Pragma("unroll") for (int k = 0; k < 2; ++k) \
        acc[ai][bj][m][n] = __builtin_amdgcn_mfma_f32_16x16x32_bf16(Bt[n][k], At[m][k], acc[ai][bj][m][n], 0, 0, 0); __builtin_amdgcn_s_setprio(0); } while (0)
#define PG8_WAIT_V(n) asm volatile("s_waitcnt vmcnt(" #n ")" ::: "memory")
#define PG8_WAIT_L(n) asm volatile("s_waitcnt lgkmcnt(" #n ")" ::: "memory")
#define PG8_BAR __builtin_amdgcn_s_barrier()
#define PG8_SCHED __builtin_amdgcn_sched_barrier(0)
    Unit cur, nxt; int ui = 0;
    if (!S.next(0, cur)) return;
    f32x4 acc[2][2][4][2];
#pragma unroll
    for (int a = 0; a < 2; ++a)
#pragma unroll
        for (int b = 0; b < 2; ++b)
#pragma unroll
            for (int m = 0; m < 4; ++m)
#pragma unroll
                for (int n = 0; n < 2; ++n) acc[a][b][m][n] = (f32x4){0.f, 0.f, 0.f, 0.f};
    bf16x8 At[4][2], B0[2][2], B1[2][2];
    const char* cA = (const char*)g.A + (size_t)cur.pm * tstep; const char* cB = (const char*)g.Bt + (size_t)cur.pn * tstep;
    S.a_ready(cur);
    PG8_STAGE(PG8_SB(0, 0), cB, voffB); PG8_STAGE(PG8_SA(0, 0), cA, voffA); PG8_STAGE(PG8_SB(0, 1), cB + hstep, voffB); PG8_STAGE(PG8_SA(0, 1), cA + hstep, voffA);
    if (wr == 1) PG8_BAR;
    PG8_WAIT_V(4); PG8_BAR;
    PG8_STAGE(PG8_SB(1, 0), cB + kstep, voffB); PG8_STAGE(PG8_SA(1, 0), cA + kstep, voffA); PG8_STAGE(PG8_SB(1, 1), cB + hstep + kstep, voffB);
    PG8_WAIT_V(6); PG8_BAR;
    for (;;) {
        const bool has_next = S.next(ui + 1, nxt);
        const char* nA = has_next ? (const char*)g.A + (size_t)nxt.pm * tstep : cA; const char* nB = has_next ? (const char*)g.Bt + (size_t)nxt.pn * tstep : cB;
        for (int t = 0; t < nt; t += 2) {
            const bool last = (t == nt - 2);
            const char* a1 = cA + (size_t)(t + 1) * kstep;
            const char* a2 = last ? nA : cA + (size_t)(t + 2) * kstep; const char* b2 = last ? nB : cB + (size_t)(t + 2) * kstep;
            const char* a3 = a2 + kstep; const char* b3 = b2 + kstep;
            if (last && has_next) S.a_ready(nxt);
            PG8_LDB(B0, 0, 0); PG8_SCHED; PG8_LDA(At, 0, 0); PG8_STAGE(PG8_SA(1, 1), a1 + hstep, voffA);
            PG8_WAIT_L(8); PG8_BAR; PG8_WAIT_L(0); PG8_MMA(0, 0, At, B0); PG8_BAR; PG8_SCHED;
            PG8_LDB(B1, 0, 1); PG8_STAGE(PG8_SB(0, 0), b2, voffB);
            PG8_BAR; PG8_WAIT_L(0); PG8_MMA(0, 1, At, B1); PG8_BAR;
            PG8_LDA(At, 0, 1); PG8_STAGE(PG8_SA(0, 0), a2, voffA);
            PG8_BAR; PG8_WAIT_L(0); PG8_MMA(1, 0, At, B0); PG8_BAR; PG8_SCHED;
            PG8_STAGE(PG8_SB(0, 1), b2 + hstep, voffB);
            PG8_WAIT_V(6); PG8_BAR; PG8_MMA(1, 1, At, B1); PG8_BAR;
            PG8_LDB(B0, 1, 0); PG8_SCHED; PG8_LDA(At, 1, 0); PG8_STAGE(PG8_SA(0, 1), a2 + hstep, voffA);
            PG8_WAIT_L(8); PG8_BAR; PG8_WAIT_L(0); PG8_MMA(0, 0, At, B0); PG8_BAR; PG8_SCHED;
            PG8_LDB(B1, 1, 1); PG8_STAGE(PG8_SB(1, 0), b3, voffB);
            PG8_BAR; PG8_WAIT_L(0); PG8_MMA(0, 1, At, B1); PG8_BAR;
            PG8_LDA(At, 1, 1); PG8_STAGE(PG8_SA(1, 0), a3, voffA);
            PG8_BAR; PG8_WAIT_L(0); PG8_MMA(1, 0, At, B0); PG8_BAR; PG8_SCHED;
            PG8_STAGE(PG8_SB(1, 1), b3 + hstep, voffB);
            PG8_WAIT_V(6); PG8_BAR; PG8_MMA(1, 1, At, B1); PG8_BAR;
        }
        E(acc, cur, wr, wc, fr, fq); S.done(cur);
        if (!has_next) break;
#pragma unroll
        for (int a = 0; a < 2; ++a)
#pragma unroll
            for (int b = 0; b < 2; ++b)
#pragma unroll
                for (int m = 0; m < 4; ++m)
#pragma unroll
                    for (int n = 0; n < 2; ++n) acc[a][b][m][n] = (f32x4){0.f, 0.f, 0.f, 0.f};
        cur = nxt; cA = nA; cB = nB; ++ui;
    }
    PG8_WAIT_V(0);
    if (wr == 0) PG8_BAR;
    PG8_BAR;
#undef PG8_SA
#undef PG8_SB
#undef PG8_STAGE
#undef PG8_LDA
#undef PG8_LDB
#undef PG8_MMA
#undef PG8_WAIT_V
#undef PG8_WAIT_L
#undef PG8_BAR
#undef PG8_SCHED
}
}

__device__ __forceinline__ void transpose_w(const float* __restrict__ W, bf16_t* __restrict__ Wt, int K, int N, int gtid, int gthr) {
    const int items = N * (K / 8);
    for (int it = gtid; it < items; it += gthr) {
        const int n = it % N, k8 = it / N;
        float f[8];
#pragma unroll
        for (int j = 0; j < 8; ++j) f[j] = W[(size_t)(k8 * 8 + j) * N + n];
        *(u32x4*)(Wt + (size_t)n * K + k8 * 8) = pack8(f);
    }
}
__device__ __forceinline__ void phase_prep(const Params& p) {
    const int gtid = blockIdx.x * NTHR + opaque_tid(), gthr = gridDim.x * NTHR;
    unsigned char* ws = p.ws;
    for (int l = 0; l < 2; ++l) {
        transpose_w(p.w_in + (size_t)l * DM * DIN, (bf16_t*)(ws + WS_WTIN) + (size_t)l * DIN * DM, DM, DIN, gtid, gthr);
        transpose_w(p.w_out + (size_t)l * DM * DM, (bf16_t*)(ws + WS_WTOUT) + (size_t)l * DM * DM, DM, DM, gtid, gthr);
    }
    bf16_t* wsb = (bf16_t*)(ws + WS_WSB);
    for (int i = gtid; i < 2 * 4 * 128 * 128; i += gthr) {
        const int s = i & 127, t = (i >> 7) & 127;
        const float v = (s <= t) ? p.sgu_w[i] : 0.f;
        wsb[i] = (bf16_t)(cvt_pk_bf16(v, 0.f) & 0xffffu);
    }
    bf16_t* xb = (bf16_t*)(ws + WS_XB);
    for (size_t i = (size_t)gtid; i < (size_t)MTOK * DM / 8; i += (size_t)gthr) {
        const f32x4 a = *(const f32x4*)(p.x + i * 8), b = *(const f32x4*)(p.x + i * 8 + 4);
        u32x4 w; w.x = cvt_pk_bf16(a[0], a[1]); w.y = cvt_pk_bf16(a[2], a[3]); w.z = cvt_pk_bf16(b[0], b[1]); w.w = cvt_pk_bf16(b[2], b[3]);
        *(u32x4*)(xb + i * 8) = w;
    }
}

__device__ __forceinline__ void sgu_chunk(const Params& p, int l, int chunk, LAS unsigned char* lds) {
    const int tid = opaque_tid(), lane = tid & 63, wid = tid >> 6;
    const bf16_t* h = (const bf16_t*)(p.ws + WS_H);
    bf16_t* y = (bf16_t*)(p.ws + WS_Y);
    const size_t t0 = (size_t)chunk * 128;
    constexpr int VS = 136;
    LAS bf16_t* vT = (LAS bf16_t*)lds;
    LAS float* mixed = (LAS float*)lds;
    {
        const int pr = tid >> 3, sl = tid & 7;
        float v[2][32];
#pragma unroll
        for (int tt = 0; tt < 2; ++tt)
#pragma unroll
            for (int g = 0; g < 4; ++g) {
                const u32x4 raw = *(const u32x4*)(h + (t0 + 2 * pr + tt) * DIN + OFF_AV + g * 64 + sl * 8);
                float f[8]; unpack8(raw, f);
#pragma unroll
                for (int i = 0; i < 8; ++i) v[tt][g * 8 + i] = gelu_tanh(f[i]);
            }
        float mean[2], rstd[2];
#pragma unroll
        for (int tt = 0; tt < 2; ++tt) {
            float s = 0.f;
#pragma unroll
            for (int i = 0; i < 32; ++i) s += v[tt][i];
            s = xor_sum8(s); mean[tt] = s * (1.0f / 256.0f);
            float q = 0.f;
#pragma unroll
            for (int i = 0; i < 32; ++i) { const float d = v[tt][i] - mean[tt]; q += d * d; }
            q = xor_sum8(q); rstd[tt] = rsqrtf(q * (1.0f / 256.0f) + LN_EPS);
        }
#pragma unroll
        for (int g = 0; g < 4; ++g)
#pragma unroll
            for (int i = 0; i < 8; ++i) {
                const int c = g * 64 + sl * 8 + i;
                const float gg = p.sgu_ln_g[l * 256 + c], bb = p.sgu_ln_b[l * 256 + c];
                const float a = (v[0][g * 8 + i] - mean[0]) * rstd[0] * gg + bb, b = (v[1][g * 8 + i] - mean[1]) * rstd[1] * gg + bb;
                *(LAS unsigned*)(vT + c * VS + 2 * pr) = cvt_pk_bf16(a, b);
            }
    }
    __syncthreads();
    const int hd = wid >> 1, th = wid & 1, fr = lane & 15, fq = lane >> 4;
    f32x4 acc[4][4];
#pragma unroll
    for (int m = 0; m < 4; ++m)
#pragma unroll
        for (int n = 0; n < 4; ++n) acc[m][n] = (f32x4){0.f, 0.f, 0.f, 0.f};
    const bf16_t* wsb = (const bf16_t*)(p.ws + WS_WSB) + ((size_t)(l * 4 + hd) * 128 + th * 64) * 128;
    const int nk = th ? 4 : 2;
    for (int kk = 0; kk < nk; ++kk) {
        bf16x8 a[4], b[4];
#pragma unroll
        for (int m = 0; m < 4; ++m) a[m] = *(const bf16x8*)(wsb + (m * 16 + fr) * 128 + kk * 32 + fq * 8);
#pragma unroll
        for (int n = 0; n < 4; ++n) b[n] = *(const LAS bf16x8*)(vT + (hd * 64 + n * 16 + fr) * VS + kk * 32 + fq * 8);
#pragma unroll
        for (int m = 0; m < 4; ++m)
#pragma unroll
            for (int n = 0; n < 4; ++n) acc[m][n] = __builtin_amdgcn_mfma_f32_16x16x32_bf16(a[m], b[n], acc[m][n], 0, 0, 0);
    }
    __syncthreads();
#pragma unroll
    for (int m = 0; m < 4; ++m)
#pragma unroll
        for (int n = 0; n < 4; ++n)
#pragma unroll
            for (int j = 0; j < 4; ++j) mixed[(th * 64 + m * 16 + fq * 4 + j) * 256 + hd * 64 + n * 16 + fr] = acc[m][n][j];
    __syncthreads();
    {
        const int t = tid >> 2, hh = tid & 3;
        const float bs = p.sgu_b[(l * 4 + hh) * 128 + t];
        const bf16_t* hrow = h + (t0 + t) * DIN;
        bf16_t* yrow = y + (t0 + t) * DM;
#pragma unroll
        for (int g = 0; g < 8; ++g) {
            const int c = hh * 64 + g * 8;
            float u[8], gt[8], o[8];
            unpack8(*(const u32x4*)(hrow + OFF_AU + c), u);
            unpack8(*(const u32x4*)(hrow + OFF_AG + c), gt);
            const f32x4 m0 = *(const LAS f32x4*)(mixed + t * 256 + c), m1 = *(const LAS f32x4*)(mixed + t * 256 + c + 4);
#pragma unroll
            for (int i = 0; i < 8; ++i) { const float mx = (i < 4 ? m0[i & 3] : m1[i & 3]) + bs; o[i] = gelu_tanh(u[i]) * mx * siluf_(gt[i]); }
            *(u32x4*)(yrow + c) = pack8(o);
        }
    }
    __syncthreads();
}

__device__ __forceinline__ void conv_tile(const Params& p, int l, int tile, LAS unsigned char* lds) {
    const int tid = opaque_tid();
    const bf16_t* h = (const bf16_t*)(p.ws + WS_H);
    bf16_t* y = (bf16_t*)(p.ws + WS_Y);
    const long t0 = (long)tile * 64;
    const long bstart = (t0 / SEQ) * SEQ;
    LAS float* hg = (LAS float*)lds;
    for (int it = tid; it < 94 * 32; it += NTHR) {
        const int r = it >> 5, c8 = (it & 31) * 8;
        const long t = t0 - 30 + r;
        float o[8];
        if (t >= bstart) {
            float a[8], b[8];
            unpack8(*(const u32x4*)(h + (size_t)t * DIN + OFF_BV + c8), a);
            unpack8(*(const u32x4*)(h + (size_t)t * DIN + OFF_BGLU + c8), b);
#pragma unroll
            for (int i = 0; i < 8; ++i) o[i] = a[i] * sigmoidf_(b[i]);
        } else {
#pragma unroll
            for (int i = 0; i < 8; ++i) o[i] = 0.f;
        }
        *(LAS f32x4*)(hg + r * 256 + c8) = (f32x4){o[0], o[1], o[2], o[3]};
        *(LAS f32x4*)(hg + r * 256 + c8 + 4) = (f32x4){o[4], o[5], o[6], o[7]};
    }
    __syncthreads();
    const int c = tid & 255, seg = tid >> 8;
    float outv[32];
    {
        float w[31];
#pragma unroll
        for (int j = 0; j < 31; ++j) w[j] = p.conv_w[(l * 31 + j) * 256 + c];
        const float bias = p.conv_b[l * 256 + c];
#pragma unroll
        for (int g = 0; g < 4; ++g) {
            float in[38];
#pragma unroll
            for (int i = 0; i < 38; ++i) in[i] = hg[(seg * 32 + g * 8 + i) * 256 + c];
#pragma unroll
            for (int o = 0; o < 8; ++o) {
                float a = bias;
#pragma unroll
                for (int j = 0; j < 31; ++j) a += w[j] * in[o + j];
                outv[g * 8 + o] = a;
            }
        }
    }
    __syncthreads();
#pragma unroll
    for (int o = 0; o < 32; ++o) hg[(seg * 32 + o) * 256 + c] = outv[o];
    __syncthreads();
    {
        const int t = tid >> 3, sl = tid & 7;
        float v[32];
#pragma unroll
        for (int i = 0; i < 8; ++i) { const f32x4 q = *(const LAS f32x4*)(hg + t * 256 + sl * 32 + i * 4); v[i * 4] = q[0]; v[i * 4 + 1] = q[1]; v[i * 4 + 2] = q[2]; v[i * 4 + 3] = q[3]; }
        float s = 0.f;
#pragma unroll
        for (int i = 0; i < 32; ++i) s += v[i];
        s = xor_sum8(s); const float mean = s * (1.0f / 256.0f);
        float q = 0.f;
#pragma unroll
        for (int i = 0; i < 32; ++i) { const float d = v[i] - mean; q += d * d; }
        q = xor_sum8(q); const float rstd = rsqrtf(q * (1.0f / 256.0f) + LN_EPS);
        const bf16_t* hrow = h + (size_t)(t0 + t) * DIN + OFF_BG + sl * 32;
        bf16_t* yrow = y + (size_t)(t0 + t) * DM + 256 + sl * 32;
#pragma unroll
        for (int g = 0; g < 4; ++g) {
            float gt[8], o[8];
            unpack8(*(const u32x4*)(hrow + g * 8), gt);
#pragma unroll
            for (int i = 0; i < 8; ++i) {
                const int cc = sl * 32 + g * 8 + i;
                const float n = (v[g * 8 + i] - mean) * rstd * p.conv_ln_g[l * 256 + cc] + p.conv_ln_b[l * 256 + cc];
                o[i] = siluf_(n) * siluf_(gt[i]);
            }
            *(u32x4*)(yrow + g * 8) = pack8(o);
        }
    }
    __syncthreads();
}

__device__ __forceinline__ float lower_bound(const Params& p, int l, int ch) {
    if (l == 0) return 0.f;
    return frcp(1.0f + fexp(p.hgrn_lb[ch] - p.hgrn_lb[512 + ch]));
}
__device__ __forceinline__ void hgrn_gates(const Params& p, int l, const bf16_t* hbase  , int d, int seg, float lb, LAS float* tot  ,
                                           float (&bcum)[16], float (&kk)[16], float& bmid, float& blast) {
    float run = 0.f;
#pragma unroll
    for (int i = 0; i < 16; ++i) {
        float z = bf2f(hbase[(size_t)(seg * 16 + i) * DIN + OFF_CF + d]);
        z = fmaxf(z, -60.f);
        const float e = fexp(-z), r = frcp(1.0f + e);
        const float f = lb + (1.0f - lb) * r;
        kk[i] = (1.0f - lb) * (e * r);
        run += __logf(f);
        bcum[i] = run;
    }
    tot[seg * 128 + d] = run;
    __syncthreads();
    const float t0 = tot[d], t1 = tot[128 + d], t2 = tot[256 + d], t3 = tot[384 + d];
    const float off = (seg > 0 ? t0 : 0.f) + (seg > 1 ? t1 : 0.f) + (seg > 2 ? t2 : 0.f);
#pragma unroll
    for (int i = 0; i < 16; ++i) bcum[i] += off;
    bmid = t0 + t1; blast = t0 + t1 + t2 + t3;
}

__device__ __forceinline__ void hgrn_local(const Params& p, int l, int unit, LAS unsigned char* lds) {
    const int tid = opaque_tid(), lane = tid & 63, wid = tid >> 6;
    const int bh = unit >> 7, chunk = unit & 127, b = bh >> 2, head = bh & 3;
    const size_t tok0 = (size_t)b * SEQ + (size_t)chunk * 64;
    const bf16_t* hbase = (const bf16_t*)(p.ws + WS_H) + tok0 * DIN + head * 128;
    constexpr int TS = 72;
    LAS bf16_t* kT = (LAS bf16_t*)lds;
    LAS bf16_t* vT = kT + 128 * TS;
    LAS float* tot = (LAS float*)(vT + 128 * TS);
    LAS float* scl = tot + 512;
    const int d = tid & 127, seg = tid >> 7;
    const float lb = lower_bound(p, l, head * 128 + d);
    float bcum[16], kk[16], bmid, blast;
    hgrn_gates(p, l, hbase, d, seg, lb, tot, bcum, kk, bmid, blast);
    {
        float kv[16], vv[16];
#pragma unroll
        for (int i = 0; i < 16; ++i) {
            kv[i] = kk[i] * fexp(fminf(bmid - bcum[i], 80.f));
            vv[i] = bf2f(hbase[(size_t)(seg * 16 + i) * DIN + OFF_CI + d]);
        }
        u32x4 w0, w1;
        w0.x = cvt_pk_bf16(kv[0], kv[1]); w0.y = cvt_pk_bf16(kv[2], kv[3]); w0.z = cvt_pk_bf16(kv[4], kv[5]); w0.w = cvt_pk_bf16(kv[6], kv[7]);
        w1.x = cvt_pk_bf16(kv[8], kv[9]); w1.y = cvt_pk_bf16(kv[10], kv[11]); w1.z = cvt_pk_bf16(kv[12], kv[13]); w1.w = cvt_pk_bf16(kv[14], kv[15]);
        *(LAS u32x4*)(kT + d * TS + seg * 16) = w0; *(LAS u32x4*)(kT + d * TS + seg * 16 + 8) = w1;
        w0.x = cvt_pk_bf16(vv[0], vv[1]); w0.y = cvt_pk_bf16(vv[2], vv[3]); w0.z = cvt_pk_bf16(vv[4], vv[5]); w0.w = cvt_pk_bf16(vv[6], vv[7]);
        w1.x = cvt_pk_bf16(vv[8], vv[9]); w1.y = cvt_pk_bf16(vv[10], vv[11]); w1.z = cvt_pk_bf16(vv[12], vv[13]); w1.w = cvt_pk_bf16(vv[14], vv[15]);
        *(LAS u32x4*)(vT + d * TS + seg * 16) = w0; *(LAS u32x4*)(vT + d * TS + seg * 16 + 8) = w1;
        if (seg == 0) {
            scl[d] = fexp(blast - bmid);
            ((float*)(p.ws + WS_DEC))[(size_t)unit * 128 + d] = fexp(blast);
        }
    }
    __syncthreads();
    const int fr = lane & 15, fq = lane >> 4, mb = wid >> 1, nh = wid & 1;
    f32x4 acc[2][4];
#pragma unroll
    for (int m = 0; m < 2; ++m)
#pragma unroll
        for (int n = 0; n < 4; ++n) acc[m][n] = (f32x4){0.f, 0.f, 0.f, 0.f};
#pragma unroll
    for (int k2 = 0; k2 < 2; ++k2) {
        bf16x8 a[2], bb[4];
#pragma unroll
        for (int m = 0; m < 2; ++m) a[m] = *(const LAS bf16x8*)(kT + (mb * 32 + m * 16 + fr) * TS + k2 * 32 + fq * 8);
#pragma unroll
        for (int n = 0; n < 4; ++n) bb[n] = *(const LAS bf16x8*)(vT + (nh * 64 + n * 16 + fr) * TS + k2 * 32 + fq * 8);
#pragma unroll
        for (int m = 0; m < 2; ++m)
#pragma unroll
            for (int n = 0; n < 4; ++n) acc[m][n] = __builtin_amdgcn_mfma_f32_16x16x32_bf16(a[m], bb[n], acc[m][n], 0, 0, 0);
    }
    bf16_t* st = (bf16_t*)(p.ws + WS_ST) + (size_t)unit * 16384;
#pragma unroll
    for (int m = 0; m < 2; ++m) {
        const int dk0 = mb * 32 + m * 16 + fq * 4;
        const f32x4 sc = *(const LAS f32x4*)(scl + dk0);
#pragma unroll
        for (int n = 0; n < 4; ++n) {
            const int dv = nh * 64 + n * 16 + fr;
            u32x2 w; w.x = cvt_pk_bf16(acc[m][n][0] * sc[0], acc[m][n][1] * sc[1]); w.y = cvt_pk_bf16(acc[m][n][2] * sc[2], acc[m][n][3] * sc[3]);
            *(u32x2*)(st + dv * 128 + dk0) = w;
        }
    }
    __syncthreads();
}

__device__ __forceinline__ void phase_scan(const Params& p) {
    const int gthr = gridDim.x * NTHR;
    for (int item = blockIdx.x * NTHR + opaque_tid(); item < 32 * 4096; item += gthr) {
        const int bh = item >> 12, rem = item & 4095, dv = rem >> 5, dk4 = rem & 31;
        bf16_t* sp = (bf16_t*)(p.ws + WS_ST) + (size_t)bh * 128 * 16384 + dv * 128 + dk4 * 4;
        const float* dp = (const float*)(p.ws + WS_DEC) + (size_t)bh * 128 * 128 + dk4 * 4;
        float s0 = 0.f, s1 = 0.f, s2 = 0.f, s3 = 0.f;
        for (int c0 = 0; c0 < 128; c0 += 8) {
            u32x2 ds[8]; f32x4 dc[8];
#pragma unroll
            for (int u = 0; u < 8; ++u) { ds[u] = *(const u32x2*)(sp + (size_t)(c0 + u) * 16384); dc[u] = *(const f32x4*)(dp + (size_t)(c0 + u) * 128); }
#pragma unroll
            for (int u = 0; u < 8; ++u) {
                u32x2 w; w.x = cvt_pk_bf16(s0, s1); w.y = cvt_pk_bf16(s2, s3);
                *(u32x2*)(sp + (size_t)(c0 + u) * 16384) = w;
                s0 = dc[u][0] * s0 + bflo(ds[u].x); s1 = dc[u][1] * s1 + bfhi(ds[u].x);
                s2 = dc[u][2] * s2 + bflo(ds[u].y); s3 = dc[u][3] * s3 + bfhi(ds[u].y);
            }
        }
    }
}

__device__ __forceinline__ void hgrn_out(const Params& p, int l, int unit, LAS unsigned char* lds) {
    const int tid = opaque_tid(), lane = tid & 63, wid = tid >> 6;
    const int bh = unit >> 7, chunk = unit & 127, b = bh >> 2, head = bh & 3;
    const size_t tok0 = (size_t)b * SEQ + (size_t)chunk * 64;
    const bf16_t* hbase = (const bf16_t*)(p.ws + WS_H) + tok0 * DIN + head * 128;
    constexpr int QS = 136, TS = 72, OS = 132;
    LAS bf16_t* q1 = (LAS bf16_t*)lds;
    LAS bf16_t* q2 = q1 + 64 * QS;
    LAS bf16_t* k1 = q2 + 64 * QS;
    LAS bf16_t* vT = k1 + 64 * QS;
    LAS bf16_t* P = vT + 128 * TS;
    LAS float* tot = (LAS float*)(P + 64 * TS);
    LAS float* ob = tot + 512;
    const int fr = lane & 15, fq = lane >> 4;
    const int tb = wid >> 1, hf = wid & 1;
    const bf16_t* st = (const bf16_t*)(p.ws + WS_ST) + (size_t)unit * 16384;
    bf16x8 sfrag[4][4];
#pragma unroll
    for (int n = 0; n < 4; ++n)
#pragma unroll
        for (int k4 = 0; k4 < 4; ++k4) sfrag[n][k4] = *(const bf16x8*)(st + (hf * 64 + n * 16 + fr) * 128 + k4 * 32 + fq * 8);
    {
        const int d = tid & 127, seg = tid >> 7;
        const float lb = lower_bound(p, l, head * 128 + d);
        float bcum[16], kk[16], bmid, blast;
        hgrn_gates(p, l, hbase, d, seg, lb, tot, bcum, kk, bmid, blast);
        float vv[16];
#pragma unroll
        for (int i = 0; i < 16; ++i) {
            const int t = seg * 16 + i;
            const float qv = siluf_(bf2f(hbase[(size_t)t * DIN + OFF_CQ + d]));
            vv[i] = bf2f(hbase[(size_t)t * DIN + OFF_CI + d]);
            const float qa = qv * fexp(fminf(bcum[i] - bmid, 80.f)), qb = qv * fexp(bcum[i]);
            const float ka = kk[i] * fexp(fminf(bmid - bcum[i], 80.f));
            q1[t * QS + d] = (bf16_t)(cvt_pk_bf16(qa, 0.f) & 0xffffu);
            q2[t * QS + d] = (bf16_t)(cvt_pk_bf16(qb, 0.f) & 0xffffu);
            k1[t * QS + d] = (bf16_t)(cvt_pk_bf16(ka, 0.f) & 0xffffu);
        }
        u32x4 w0, w1;
        w0.x = cvt_pk_bf16(vv[0], vv[1]); w0.y = cvt_pk_bf16(vv[2], vv[3]); w0.z = cvt_pk_bf16(vv[4], vv[5]); w0.w = cvt_pk_bf16(vv[6], vv[7]);
        w1.x = cvt_pk_bf16(vv[8], vv[9]); w1.y = cvt_pk_bf16(vv[10], vv[11]); w1.z = cvt_pk_bf16(vv[12], vv[13]); w1.w = cvt_pk_bf16(vv[14], vv[15]);
        *(LAS u32x4*)(vT + d * TS + seg * 16) = w0; *(LAS u32x4*)(vT + d * TS + seg * 16 + 8) = w1;
    }
    __syncthreads();
#pragma unroll
    for (int sbi = 0; sbi < 2; ++sbi) {
        const int sb = hf * 2 + sbi;
        f32x4 sc = (f32x4){0.f, 0.f, 0.f, 0.f};
        if (sb <= tb) {
#pragma unroll
            for (int k4 = 0; k4 < 4; ++k4) {
                const bf16x8 a = *(const LAS bf16x8*)(q1 + (tb * 16 + fr) * QS + k4 * 32 + fq * 8);
                const bf16x8 bb = *(const LAS bf16x8*)(k1 + (sb * 16 + fr) * QS + k4 * 32 + fq * 8);
                sc = __builtin_amdgcn_mfma_f32_16x16x32_bf16(a, bb, sc, 0, 0, 0);
            }
        }
#pragma unroll
        for (int j = 0; j < 4; ++j) {
            const int t = tb * 16 + fq * 4 + j, s = sb * 16 + fr;
            const float v = (sb <= tb && s <= t) ? sc[j] : 0.f;
            P[t * TS + s] = (bf16_t)(cvt_pk_bf16(v, 0.f) & 0xffffu);
        }
    }
    __syncthreads();
    f32x4 acc[4];
#pragma unroll
    for (int n = 0; n < 4; ++n) acc[n] = (f32x4){0.f, 0.f, 0.f, 0.f};
#pragma unroll
    for (int k2 = 0; k2 < 2; ++k2) {
        const bf16x8 a = *(const LAS bf16x8*)(P + (tb * 16 + fr) * TS + k2 * 32 + fq * 8);
#pragma unroll
        for (int n = 0; n < 4; ++n) {
            const bf16x8 bb = *(const LAS bf16x8*)(vT + (hf * 64 + n * 16 + fr) * TS + k2 * 32 + fq * 8);
            acc[n] = __builtin_amdgcn_mfma_f32_16x16x32_bf16(a, bb, acc[n], 0, 0, 0);
        }
    }
#pragma unroll
    for (int k4 = 0; k4 < 4; ++k4) {
        const bf16x8 a = *(const LAS bf16x8*)(q2 + (tb * 16 + fr) * QS + k4 * 32 + fq * 8);
#pragma unroll
        for (int n = 0; n < 4; ++n) acc[n] = __builtin_amdgcn_mfma_f32_16x16x32_bf16(a, sfrag[n][k4], acc[n], 0, 0, 0);
    }
#pragma unroll
    for (int n = 0; n < 4; ++n)
#pragma unroll
        for (int j = 0; j < 4; ++j) ob[(tb * 16 + fq * 4 + j) * OS + hf * 64 + n * 16 + fr] = acc[n][j];
    __syncthreads();
    {
        const int t = tid >> 3, sl = tid & 7;
        float v[16];
#pragma unroll
        for (int i = 0; i < 4; ++i) { const f32x4 q = *(const LAS f32x4*)(ob + t * OS + sl * 16 + i * 4); v[i * 4] = q[0]; v[i * 4 + 1] = q[1]; v[i * 4 + 2] = q[2]; v[i * 4 + 3] = q[3]; }
        float s = 0.f;
#pragma unroll
        for (int i = 0; i < 16; ++i) s += v[i] * v[i];
        s = xor_sum8(s);
        const float r = rsqrtf(s * (1.0f / 128.0f) + LN_EPS);
        const bf16_t* grow = hbase + (size_t)t * DIN + OFF_CG + sl * 16;
        bf16_t* yrow = (bf16_t*)(p.ws + WS_Y) + (tok0 + t) * DM + 512 + head * 128 + sl * 16;
#pragma unroll
        for (int g = 0; g < 2; ++g) {
            float gt[8], o[8];
            unpack8(*(const u32x4*)(grow + g * 8), gt);
#pragma unroll
            for (int i = 0; i < 8; ++i) o[i] = v[g * 8 + i] * r * p.hgrn_norm_g[l * 512 + head * 128 + sl * 16 + g * 8 + i] * siluf_(gt[i]);
            *(u32x4*)(yrow + g * 8) = pack8(o);
        }
    }
    __syncthreads();
}

__device__ __forceinline__ void phase_ln(const Params& p, int l) {
    const int tid = opaque_tid(), lane = tid & 63, gw = blockIdx.x * (NTHR / 64) + (tid >> 6), nw = gridDim.x * (NTHR / 64);
    const float* z = (const float*)(p.ws + WS_Z);
    bf16_t* xb = (bf16_t*)(p.ws + WS_XB);
    const float* g = p.post_ln_g + l * DM; const float* bb = p.post_ln_b + l * DM;
    for (int row = gw; row < MTOK; row += nw) {
        f32x4 v[4];
#pragma unroll
        for (int i = 0; i < 4; ++i) v[i] = *(const f32x4*)(z + (size_t)row * DM + i * 256 + lane * 4);
        float s = 0.f;
#pragma unroll
        for (int i = 0; i < 4; ++i) s += v[i][0] + v[i][1] + v[i][2] + v[i][3];
#pragma unroll
        for (int o = 1; o < 64; o <<= 1) s += __shfl_xor(s, o);
        const float mean = s * (1.0f / 1024.0f);
        float q = 0.f;
#pragma unroll
        for (int i = 0; i < 4; ++i)
#pragma unroll
            for (int j = 0; j < 4; ++j) { const float d = v[i][j] - mean; q += d * d; }
#pragma unroll
        for (int o = 1; o < 64; o <<= 1) q += __shfl_xor(q, o);
        const float rstd = rsqrtf(q * (1.0f / 1024.0f) + LN_EPS);
#pragma unroll
        for (int i = 0; i < 4; ++i) {
            const int c = i * 256 + lane * 4;
            const f32x4 gg = *(const f32x4*)(g + c), b4 = *(const f32x4*)(bb + c);
            f32x4 o;
#pragma unroll
            for (int j = 0; j < 4; ++j) o[j] = (v[i][j] - mean) * rstd * gg[j] + b4[j];
            *(f32x4*)(p.out + (size_t)row * DM + c) = o;
            if (l == 0) { u32x2 w; w.x = cvt_pk_bf16(o[0], o[1]); w.y = cvt_pk_bf16(o[2], o[3]); *(u32x2*)(xb + (size_t)row * DM + c) = w; }
        }
    }
}

__global__ void __launch_bounds__(NTHR, 2) mega_fwd(Params p) {
    extern __shared__ __attribute__((aligned(16))) unsigned char lds_raw[];
    LAS unsigned char* lds = (LAS unsigned char*)lds_raw;
    cg::grid_group grid = cg::this_grid();
    for (int ph = p.ph_lo; ph < p.ph_hi; ++ph) {
        if (ph > p.ph_lo) grid.sync();
        if (ph == 0) { phase_prep(p); continue; }
        const int l = (ph - 1) / 6, sub = (ph - 1) % 6;
        if (sub == 0) {
            pg8::Gemm g{(const bf16_t*)(p.ws + WS_XB), (const bf16_t*)(p.ws + WS_WTIN) + (size_t)l * DIN * DM, MTOK, DIN, DM};
            pg8::StaticOrder S; S.init(MTOK, DIN, gridDim.x, blockIdx.x);
            pg8::EpiH E{(bf16_t*)(p.ws + WS_H), DIN};
            pg8::gemm_phase(lds, g, S, E);
        } else if (sub == 1) {
            for (int u = blockIdx.x; u < 512; u += gridDim.x) sgu_chunk(p, l, u, lds);
            for (int u = blockIdx.x; u < 1024; u += gridDim.x) conv_tile(p, l, u, lds);
            for (int u = blockIdx.x; u < 4096; u += gridDim.x) hgrn_local(p, l, u, lds);
        } else if (sub == 2) {
            phase_scan(p);
        } else if (sub == 3) {
            for (int u = blockIdx.x; u < 4096; u += gridDim.x) hgrn_out(p, l, u, lds);
        } else if (sub == 4) {
            pg8::Gemm g{(const bf16_t*)(p.ws + WS_Y), (const bf16_t*)(p.ws + WS_WTOUT) + (size_t)l * DM * DM, MTOK, DM, DM};
            pg8::StaticOrder S; S.init(MTOK, DM, gridDim.x, blockIdx.x);
            pg8::EpiZ E{(float*)(p.ws + WS_Z), l == 0 ? p.x : p.out, DM};
            pg8::gemm_phase(lds, g, S, E);
        } else {
            phase_ln(p, l);
        }
    }
}

extern "C" void kernel_launch(void* const* d_in, const int* in_sizes, int n_in, void* d_out, int out_size, void* d_ws, size_t ws_size, hipStream_t stream) {
    static int grid_blocks = 0;
    if (!grid_blocks) {
        int dev = 0, cus = 0, per_cu = 0;
        hipGetDevice(&dev);
        hipDeviceGetAttribute(&cus, hipDeviceAttributeMultiprocessorCount, dev);
        hipFuncSetAttribute((const void*)mega_fwd, hipFuncAttributeMaxDynamicSharedMemorySize, LDS_BYTES);
        hipOccupancyMaxActiveBlocksPerMultiprocessor(&per_cu, (const void*)mega_fwd, NTHR, LDS_BYTES);
        if (per_cu < 1) { fprintf(stderr, "occupancy query returned %d\n", per_cu); per_cu = 1; }
        if (per_cu > 1) per_cu = 1;
        grid_blocks = cus * per_cu;
        if (ws_size < WS_END) fprintf(stderr, "workspace too small: %zu < %zu\n", ws_size, (size_t)WS_END);
    }
    Params p{};
    p.x = (const float*)d_in[0]; p.w_in = (const float*)d_in[1]; p.sgu_ln_g = (const float*)d_in[2]; p.sgu_ln_b = (const float*)d_in[3];
    p.sgu_w = (const float*)d_in[4]; p.sgu_b = (const float*)d_in[5]; p.conv_w = (const float*)d_in[6]; p.conv_b = (const float*)d_in[7];
    p.conv_ln_g = (const float*)d_in[8]; p.conv_ln_b = (const float*)d_in[9]; p.hgrn_lb = (const float*)d_in[10]; p.hgrn_norm_g = (const float*)d_in[11];
    p.w_out = (const float*)d_in[12]; p.post_ln_g = (const float*)d_in[13]; p.post_ln_b = (const float*)d_in[14];
    p.out = (float*)d_out; p.ws = (unsigned char*)d_ws;
    p.ph_lo = 0; p.ph_hi = 13;
    void* args[] = {&p};
    hipError_t e = hipLaunchCooperativeKernel((const void*)mega_fwd, dim3(grid_blocks), dim3(NTHR), args, LDS_BYTES, stream);
    if (e != hipSuccess) fprintf(stderr, "cooperative launch failed: %s (grid %d)\n", hipGetErrorString(e), grid_blocks);
}
```

```cpp
#include <hip/hip_runtime.h>
#include <hip/hip_cooperative_groups.h>
#include <cstdio>
namespace cg = cooperative_groups;

#define LAS __attribute__((address_space(3)))
typedef unsigned short bf16_t;
typedef short bf16x8 __attribute__((ext_vector_type(8)));
typedef float f32x4 __attribute__((ext_vector_type(4)));
typedef unsigned u32x4 __attribute__((ext_vector_type(4)));
typedef unsigned u32x2 __attribute__((ext_vector_type(2)));

constexpr int MTOK = 65536, DM = 1024, DIN = 3584, SEQ = 8192, NB = 8;
constexpr int OFF_AU = 0, OFF_AV = 256, OFF_AG = 512, OFF_BV = 768, OFF_BGLU = 1024, OFF_BG = 1280, OFF_CQ = 1536, OFF_CF = 2048, OFF_CI = 2560, OFF_CG = 3072;
constexpr float LN_EPS = 1e-5f;
constexpr float ALPHA = 1.41421356237309515f;
constexpr int NTHR = 512;
constexpr int LDS_BYTES = 139264;
#ifndef REP_G1
#define REP_G1 1
#endif
#ifndef REP_M1A
#define REP_M1A 1
#endif
#ifndef REP_M1B
#define REP_M1B 1
#endif
#ifndef REP_M1C
#define REP_M1C 1
#endif
#ifndef REP_M3
#define REP_M3 1
#endif
#ifndef REP_G2
#define REP_G2 1
#endif
#ifndef REP_LN
#define REP_LN 1
#endif

constexpr size_t WS_WTIN = 0;
constexpr size_t WS_WTOUT = WS_WTIN + 2ull * 3584 * 1024 * 2;
constexpr size_t WS_WSB = WS_WTOUT + 2ull * 1024 * 1024 * 2;
constexpr size_t WS_DEC = WS_WSB + 2ull * 4 * 128 * 128 * 2;
constexpr size_t WS_XB = WS_DEC + 4096ull * 128 * 4;
constexpr size_t WS_Y = WS_XB + (size_t)MTOK * DM * 2;
constexpr size_t WS_ST = WS_Y + (size_t)MTOK * DM * 2;
constexpr size_t WS_H = WS_ST + 4096ull * 16384 * 2;
constexpr size_t WS_Z = WS_H;
constexpr size_t WS_END = WS_H + (size_t)MTOK * DIN * 2;

struct Params {
    const float* x; const float* w_in; const float* sgu_ln_g; const float* sgu_ln_b; const float* sgu_w; const float* sgu_b;
    const float* conv_w; const float* conv_b; const float* conv_ln_g; const float* conv_ln_b; const float* hgrn_lb; const float* hgrn_norm_g;
    const float* w_out; const float* post_ln_g; const float* post_ln_b;
    float* out; unsigned char* ws;
    int ph_lo, ph_hi;
};

typedef __bf16 bf16x2_t __attribute__((ext_vector_type(2)));
typedef float f32x2_t __attribute__((ext_vector_type(2)));
__device__ __forceinline__ unsigned cvt_pk_bf16(float lo, float hi) { f32x2_t v = {lo, hi}; bf16x2_t r = __builtin_convertvector(v, bf16x2_t); return __builtin_bit_cast(unsigned, r); }
__device__ __forceinline__ float bflo(unsigned u) { return __uint_as_float(u << 16); }
__device__ __forceinline__ float bfhi(unsigned u) { return __uint_as_float(u & 0xffff0000u); }
__device__ __forceinline__ float bf2f(bf16_t b) { return __uint_as_float(((unsigned)b) << 16); }
__device__ __forceinline__ float fexp(float x) { return __builtin_amdgcn_exp2f(x * 1.44269504088896341f); }
__device__ __forceinline__ float frcp(float x) { return __builtin_amdgcn_rcpf(x); }
__device__ __forceinline__ float sigmoidf_(float x) { return frcp(1.0f + fexp(-x)); }
__device__ __forceinline__ float siluf_(float x) { return x * sigmoidf_(x); }
__device__ __forceinline__ float gelu_tanh(float x) { const float y = 1.5957691216057308f * (x + 0.044715f * x * x * x); return x * sigmoidf_(y); }
__device__ __forceinline__ void unpack8(const u32x4 v, float (&f)[8]) {
    f[0] = bflo(v.x); f[1] = bfhi(v.x); f[2] = bflo(v.y); f[3] = bfhi(v.y); f[4] = bflo(v.z); f[5] = bfhi(v.z); f[6] = bflo(v.w); f[7] = bfhi(v.w);
}
__device__ __forceinline__ u32x4 pack8(const float (&f)[8]) {
    u32x4 r; r.x = cvt_pk_bf16(f[0], f[1]); r.y = cvt_pk_bf16(f[2], f[3]); r.z = cvt_pk_bf16(f[4], f[5]); r.w = cvt_pk_bf16(f[6], f[7]); return r;
}
__device__ __forceinline__ int opaque_tid() { int t = threadIdx.x; asm volatile("" : "+v"(t)); return t; }
__device__ __forceinline__ float xor_sum8(float v) {
    v += __shfl_xor(v, 1); v += __shfl_xor(v, 2); v += __shfl_xor(v, 4); return v;
}

namespace pg8 {
constexpr int BM = 256, BK = 64, HALF = 128, HTB = HALF * BK * 2, STAGE_BYTES = 8 * HTB, NXCD = 8, WGM = 8;
__host__ __device__ __forceinline__ int lds_byte(int r, int c) { const int st = (r >> 4) * 2 + (c >> 5), rr = r & 15, cc = c & 31, ob = rr * 64 + cc * 2; return st * 1024 + (ob ^ (((ob >> 9) & 1) << 5)); }
__host__ __device__ __forceinline__ void stage_rc(int b, int& R, int& C) { const int st = b / 1024, sb = b % 1024, swz = sb ^ (((sb >> 9) & 1) << 5); R = (st >> 1) * 16 + swz / 64; C = (st & 1) * 32 + (swz % 64) / 2; }
__host__ __device__ __forceinline__ int perm32(int rho) { const int n = rho >> 4, i = rho & 15; return 8 * (i >> 2) + 4 * n + (i & 3); }
struct Unit { int pm, pn; };
struct Gemm { const bf16_t* A; const bf16_t* Bt; int M, N, K; };
struct StaticOrder {
    int nM, nN, nwg, G, c;
    __host__ __device__ void init(int M, int N, int G_, int c_) { nM = M / BM; nN = N / BM; nwg = nM * nN; G = G_; c = c_; }
    __host__ __device__ bool next(int i, Unit& u) const {
        const long L = (long)i * G + c; if (L >= nwg) return false;
        int wgid = (int)L; { const int q = nwg / NXCD, r = nwg % NXCD, xcd = wgid % NXCD, off = wgid / NXCD; wgid = (xcd < r ? xcd * (q + 1) : r * (q + 1) + (xcd - r) * q) + off; }
        const int nig = WGM * nN, gid = wgid / nig, fm = gid * WGM, gsz = (nM - fm) < WGM ? (nM - fm) : WGM;
        u.pm = fm + ((wgid % nig) % gsz); u.pn = (wgid % nig) / gsz; return true;
    }
    __device__ __forceinline__ void a_ready(const Unit&) const {}
    __device__ __forceinline__ void done(const Unit&) const {}
};
struct EpiH {
    static constexpr bool PERM = true;
    bf16_t* O; int ldc;
    __device__ __forceinline__ void operator()(const f32x4 (&acc)[2][2][4][2], const Unit& u, int wr, int wc, int fr, int fq) const {
        const int row0 = u.pm * BM + wr * 64 + fr; const int col0 = u.pn * BM + wc * 32 + 8 * fq;
#pragma unroll
        for (int ai = 0; ai < 2; ++ai)
#pragma unroll
            for (int m = 0; m < 4; ++m) { bf16_t* rowp = O + (size_t)(row0 + ai * HALF + m * 16) * ldc + col0;
#pragma unroll
                for (int bj = 0; bj < 2; ++bj) { const f32x4 v0 = acc[ai][bj][m][0], v1 = acc[ai][bj][m][1];
                    u32x4 w; w.x = cvt_pk_bf16(v0[0], v0[1]); w.y = cvt_pk_bf16(v0[2], v0[3]); w.z = cvt_pk_bf16(v1[0], v1[1]); w.w = cvt_pk_bf16(v1[2], v1[3]);
                    *(u32x4*)(rowp + bj * HALF) = w; } }
    }
};
struct EpiZ {
    static constexpr bool PERM = false;
    float* C; const float* R; int ldc;
    __device__ __forceinline__ void operator()(const f32x4 (&acc)[2][2][4][2], const Unit& u, int wr, int wc, int fr, int fq) const {
        const int row0 = u.pm * BM + wr * 64 + fr, col0 = u.pn * BM + wc * 32 + 4 * fq;
#pragma unroll
        for (int ai = 0; ai < 2; ++ai)
#pragma unroll
            for (int m = 0; m < 4; ++m) { const size_t ro = (size_t)(row0 + ai * HALF + m * 16) * ldc + col0;
#pragma unroll
                for (int bj = 0; bj < 2; ++bj)
#pragma unroll
                    for (int n = 0; n < 2; ++n) { const f32x4 r = *(const f32x4*)(R + ro + bj * HALF + n * 16);
                        *(f32x4*)(C + ro + bj * HALF + n * 16) = acc[ai][bj][m][n] + r * ALPHA; } }
    }
};

template <class Epi, class Sched>
__device__ __forceinline__ void gemm_phase(LAS unsigned char* lds, const Gemm g, const Sched& S, const Epi& E) {
    const int tid = opaque_tid(), wid = __builtin_amdgcn_readfirstlane(tid >> 6), lane = tid & 63, wr = wid >> 2, wc = wid & 3, fr = lane & 15, fq = lane >> 4;
    const int K = g.K, nt = K / BK;
    unsigned voffA[2], voffB[2];
#pragma unroll
    for (int i = 0; i < 2; ++i) { int R, C; stage_rc(tid * 16 + i * 8192, R, C); const int Rb = Epi::PERM ? ((R & ~31) + perm32(R & 31)) : R;
        voffA[i] = (unsigned)(R * K + C) * 2u; voffB[i] = (unsigned)(Rb * K + C) * 2u; }
    const size_t kstep = (size_t)(BK * 2);
    const size_t hstep = (size_t)HALF * K * 2;
    const size_t tstep = 2 * hstep;
    const unsigned ldsw = (unsigned)wid * 1024u;
    const int aoff = lds_byte(wr * 64 + fr, fq * 8), boff = lds_byte(wc * 32 + fr, fq * 8);
#define PG8_SA(b, h) (((b) * 2 + (h)) * HTB)
#define PG8_SB(b, h) ((4 + (b) * 2 + (h)) * HTB)
#define PG8_STAGE(bufoff, gbase, voff) do { _Pragma("unroll") for (int _i = 0; _i < 2; ++_i) \
        __builtin_amdgcn_global_load_lds((const unsigned*)((const char*)(gbase) + (voff)[_i]), (LAS unsigned*)(lds + (bufoff) + ldsw + _i * 8192), 16, 0, 0); } while (0)
#define PG8_LDA(dst, b, h) do { _Pragma("unroll") for (int m = 0; m < 4; ++m) _Pragma("unroll") for (int k = 0; k < 2; ++k) dst[m][k] = *(const LAS bf16x8*)(lds + PG8_SA(b, h) + aoff + m * 2048 + k * 1024); } while (0)
#define PG8_LDB(dst, b, h) do { _Pragma("unroll") for (int n = 0; n < 2; ++n) _Pragma("unroll") for (int k = 0; k < 2; ++k) dst[n][k] = *(const LAS bf16x8*)(lds + PG8_SB(b, h) + boff + n * 2048 + k * 1024); } while (0)
#define PG8_MMA(ai, bj, At, Bt) do { __builtin_amdgcn_s_setprio(1); _Pragma("unroll") for (int m = 0; m < 4; ++m) _Pragma("unroll") for (int n = 0; n < 2; ++n) _Pragma("unroll") for (int k = 0; k < 2; ++k) \
        acc[ai][bj][m][n] = __builtin_amdgcn_mfma_f32_16x16x32_bf16(Bt[n][k], At[m][k], acc[ai][bj][m][n], 0, 0, 0); __builtin_amdgcn_s_setprio(0); } while (0)
#define PG8_WAIT_V(n) asm volatile("s_waitcnt vmcnt(" #n ")" ::: "memory")
#define PG8_WAIT_L(n) asm volatile("s_waitcnt lgkmcnt(" #n ")" ::: "memory")
#define PG8_BAR __builtin_amdgcn_s_barrier()
#define PG8_SCHED __builtin_amdgcn_sched_barrier(0)
    Unit cur, nxt; int ui = 0;
    if (!S.next(0, cur)) return;
    f32x4 acc[2][2][4][2];
#pragma unroll
    for (int a = 0; a < 2; ++a)
#pragma unroll
        for (int b = 0; b < 2; ++b)
#pragma unroll
            for (int m = 0; m < 4; ++m)
#pragma unroll
                for (int n = 0; n < 2; ++n) acc[a][b][m][n] = (f32x4){0.f, 0.f, 0.f, 0.f};
    bf16x8 At[4][2], B0[2][2], B1[2][2];
    const char* cA = (const char*)g.A + (size_t)cur.pm * tstep; const char* cB = (const char*)g.Bt + (size_t)cur.pn * tstep;
    S.a_ready(cur);
    PG8_STAGE(PG8_SB(0, 0), cB, voffB); PG8_STAGE(PG8_SA(0, 0), cA, voffA); PG8_STAGE(PG8_SB(0, 1), cB + hstep, voffB); PG8_STAGE(PG8_SA(0, 1), cA + hstep, voffA);
    if (wr == 1) PG8_BAR;
    PG8_WAIT_V(4); PG8_BAR;
    PG8_STAGE(PG8_SB(1, 0), cB + kstep, voffB); PG8_STAGE(PG8_SA(1, 0), cA + kstep, voffA); PG8_STAGE(PG8_SB(1, 1), cB + hstep + kstep, voffB);
    PG8_WAIT_V(6); PG8_BAR;
    for (;;) {
        const bool has_next = S.next(ui + 1, nxt);
        const char* nA = has_next ? (const char*)g.A + (size_t)nxt.pm * tstep : cA; const char* nB = has_next ? (const char*)g.Bt + (size_t)nxt.pn * tstep : cB;
        for (int t = 0; t < nt; t += 2) {
            const bool last = (t == nt - 2);
            const char* a1 = cA + (size_t)(t + 1) * kstep;
            const char* a2 = last ? nA : cA + (size_t)(t + 2) * kstep; const char* b2 = last ? nB : cB + (size_t)(t + 2) * kstep;
            const char* a3 = a2 + kstep; const char* b3 = b2 + kstep;
            if (last && has_next) S.a_ready(nxt);
            PG8_LDB(B0, 0, 0); PG8_SCHED; PG8_LDA(At, 0, 0); PG8_STAGE(PG8_SA(1, 1), a1 + hstep, voffA);
            PG8_WAIT_L(8); PG8_BAR; PG8_WAIT_L(0); PG8_MMA(0, 0, At, B0); PG8_BAR; PG8_SCHED;
            PG8_LDB(B1, 0, 1); PG8_STAGE(PG8_SB(0, 0), b2, voffB);
            PG8_BAR; PG8_WAIT_L(0); PG8_MMA(0, 1, At, B1); PG8_BAR;
            PG8_LDA(At, 0, 1); PG8_STAGE(PG8_SA(0, 0), a2, voffA);
            PG8_BAR; PG8_WAIT_L(0); PG8_MMA(1, 0, At, B0); PG8_BAR; PG8_SCHED;
            PG8_STAGE(PG8_SB(0, 1), b2 + hstep, voffB);
            PG8_WAIT_V(6); PG8_BAR; PG8_MMA(1, 1, At, B1); PG8_BAR;
            PG8_LDB(B0, 1, 0); PG8_SCHED; PG8_LDA(At, 1, 0); PG8_STAGE(PG8_SA(0, 1), a2 + hstep, voffA);
            PG8_WAIT_L(8); PG8_BAR; PG8_WAIT_L(0); PG8_MMA(0, 0, At, B0); PG8_BAR; PG8_SCHED;
            PG8_LDB(B1, 1, 1); PG8_STAGE(PG8_SB(1, 0), b3, voffB);
            PG8_BAR; PG8_WAIT_L(0); PG8_MMA(0, 1, At, B1); PG8_BAR;
            PG8_LDA(At, 1, 1); PG8_STAGE(PG8_SA(1, 0), a3, voffA);
            PG8_BAR; PG8_WAIT_L(0); PG8_MMA(1, 0, At, B0); PG8_BAR; PG8_SCHED;
            PG8_STAGE(PG8_SB(1, 1), b3 + hstep, voffB);
            PG8_WAIT_V(6); PG8_BAR; PG8_MMA(1, 1, At, B1); PG8_BAR;
        }
        E(acc, cur, wr, wc, fr, fq); S.done(cur);
        if (!has_next) break;
#pragma unroll
        for (int a = 0; a < 2; ++a)
#pragma unroll
            for (int b = 0; b < 2; ++b)
#pragma unroll
                for (int m = 0; m < 4; ++m)
#pragma unroll
                    for (int n = 0; n < 2; ++n) acc[a][b][m][n] = (f32x4){0.f, 0.f, 0.f, 0.f};
        cur = nxt; cA = nA; cB = nB; ++ui;
    }
    PG8_WAIT_V(0);
    if (wr == 0) PG8_BAR;
    PG8_BAR;
#undef PG8_SA
#undef PG8_SB
#undef PG8_STAGE
#undef PG8_LDA
#undef PG8_LDB
#undef PG8_MMA
#undef PG8_WAIT_V
#undef PG8_WAIT_L
#undef PG8_BAR
#undef PG8_SCHED
}
}

__device__ __forceinline__ void transpose_w(const float* __restrict__ W, bf16_t* __restrict__ Wt, int K, int N, int gtid, int gthr) {
    const int items = N * (K / 8);
    for (int it = gtid; it < items; it += gthr) {
        const int n = it % N, k8 = it / N;
        float f[8];
#pragma unroll
        for (int j = 0; j < 8; ++j) f[j] = W[(size_t)(k8 * 8 + j) * N + n];
        *(u32x4*)(Wt + (size_t)n * K + k8 * 8) = pack8(f);
    }
}
__device__ __forceinline__ void phase_prep(const Params& p) {
    const int gtid = blockIdx.x * NTHR + opaque_tid(), gthr = gridDim.x * NTHR;
    unsigned char* ws = p.ws;
    for (int l = 0; l < 2; ++l) {
        transpose_w(p.w_in + (size_t)l * DM * DIN, (bf16_t*)(ws + WS_WTIN) + (size_t)l * DIN * DM, DM, DIN, gtid, gthr);
        transpose_w(p.w_out + (size_t)l * DM * DM, (bf16_t*)(ws + WS_WTOUT) + (size_t)l * DM * DM, DM, DM, gtid, gthr);
    }
    bf16_t* wsb = (bf16_t*)(ws + WS_WSB);
    for (int i = gtid; i < 2 * 4 * 128 * 128; i += gthr) {
        const int s = i & 127, t = (i >> 7) & 127;
        const float v = (s <= t) ? p.sgu_w[i] : 0.f;
        wsb[i] = (bf16_t)(cvt_pk_bf16(v, 0.f) & 0xffffu);
    }
    bf16_t* xb = (bf16_t*)(ws + WS_XB);
    for (size_t i = (size_t)gtid; i < (size_t)MTOK * DM / 8; i += (size_t)gthr) {
        const f32x4 a = *(const f32x4*)(p.x + i * 8), b = *(const f32x4*)(p.x + i * 8 + 4);
        u32x4 w; w.x = cvt_pk_bf16(a[0], a[1]); w.y = cvt_pk_bf16(a[2], a[3]); w.z = cvt_pk_bf16(b[0], b[1]); w.w = cvt_pk_bf16(b[2], b[3]);
        *(u32x4*)(xb + i * 8) = w;
    }
}

__device__ __forceinline__ void sgu_chunk(const Params& p, int l, int chunk, LAS unsigned char* lds) {
    const int tid = opaque_tid(), lane = tid & 63, wid = tid >> 6;
    const bf16_t* h = (const bf16_t*)(p.ws + WS_H);
    bf16_t* y = (bf16_t*)(p.ws + WS_Y);
    const size_t t0 = (size_t)chunk * 128;
    constexpr int VS = 136;
    LAS bf16_t* vT = (LAS bf16_t*)lds;
    LAS float* mixed = (LAS float*)lds;
    {
        const int pr = tid >> 3, sl = tid & 7;
        float v[2][32];
#pragma unroll
        for (int tt = 0; tt < 2; ++tt)
#pragma unroll
            for (int g = 0; g < 4; ++g) {
                const u32x4 raw = *(const u32x4*)(h + (t0 + 2 * pr + tt) * DIN + OFF_AV + g * 64 + sl * 8);
                float f[8]; unpack8(raw, f);
#pragma unroll
                for (int i = 0; i < 8; ++i) v[tt][g * 8 + i] = gelu_tanh(f[i]);
            }
        float mean[2], rstd[2];
#pragma unroll
        for (int tt = 0; tt < 2; ++tt) {
            float s = 0.f;
#pragma unroll
            for (int i = 0; i < 32; ++i) s += v[tt][i];
            s = xor_sum8(s); mean[tt] = s * (1.0f / 256.0f);
            float q = 0.f;
#pragma unroll
            for (int i = 0; i < 32; ++i) { const float d = v[tt][i] - mean[tt]; q += d * d; }
            q = xor_sum8(q); rstd[tt] = rsqrtf(q * (1.0f / 256.0f) + LN_EPS);
        }
#pragma unroll
        for (int g = 0; g < 4; ++g)
#pragma unroll
            for (int i = 0; i < 8; ++i) {
                const int c = g * 64 + sl * 8 + i;
                const float gg = p.sgu_ln_g[l * 256 + c], bb = p.sgu_ln_b[l * 256 + c];
                const float a = (v[0][g * 8 + i] - mean[0]) * rstd[0] * gg + bb, b = (v[1][g * 8 + i] - mean[1]) * rstd[1] * gg + bb;
                *(LAS unsigned*)(vT + c * VS + 2 * pr) = cvt_pk_bf16(a, b);
            }
    }
    __syncthreads();
    const int hd = wid >> 1, th = wid & 1, fr = lane & 15, fq = lane >> 4;
    f32x4 acc[4][4];
#pragma unroll
    for (int m = 0; m < 4; ++m)
#pragma unroll
        for (int n = 0; n < 4; ++n) acc[m][n] = (f32x4){0.f, 0.f, 0.f, 0.f};
    const bf16_t* wsb = (const bf16_t*)(p.ws + WS_WSB) + ((size_t)(l * 4 + hd) * 128 + th * 64) * 128;
    const int nk = th ? 4 : 2;
    for (int kk = 0; kk < nk; ++kk) {
        bf16x8 a[4], b[4];
#pragma unroll
        for (int m = 0; m < 4; ++m) a[m] = *(const bf16x8*)(wsb + (m * 16 + fr) * 128 + kk * 32 + fq * 8);
#pragma unroll
        for (int n = 0; n < 4; ++n) b[n] = *(const LAS bf16x8*)(vT + (hd * 64 + n * 16 + fr) * VS + kk * 32 + fq * 8);
#pragma unroll
        for (int m = 0; m < 4; ++m)
#pragma unroll
            for (int n = 0; n < 4; ++n) acc[m][n] = __builtin_amdgcn_mfma_f32_16x16x32_bf16(a[m], b[n], acc[m][n], 0, 0, 0);
    }
    __syncthreads();
#pragma unroll
    for (int m = 0; m < 4; ++m)
#pragma unroll
        for (int n = 0; n < 4; ++n)
#pragma unroll
            for (int j = 0; j < 4; ++j) mixed[(th * 64 + m * 16 + fq * 4 + j) * 256 + hd * 64 + n * 16 + fr] = acc[m][n][j];
    __syncthreads();
    {
        const int t = tid >> 2, hh = tid & 3;
        const float bs = p.sgu_b[(l * 4 + hh) * 128 + t];
        const bf16_t* hrow = h + (t0 + t) * DIN;
        bf16_t* yrow = y + (t0 + t) * DM;
#pragma unroll
        for (int g = 0; g < 8; ++g) {
            const int c = hh * 64 + g * 8;
            float u[8], gt[8], o[8];
            unpack8(*(const u32x4*)(hrow + OFF_AU + c), u);
            unpack8(*(const u32x4*)(hrow + OFF_AG + c), gt);
            const f32x4 m0 = *(const LAS f32x4*)(mixed + t * 256 + c), m1 = *(const LAS f32x4*)(mixed + t * 256 + c + 4);
#pragma unroll
            for (int i = 0; i < 8; ++i) { const float mx = (i < 4 ? m0[i & 3] : m1[i & 3]) + bs; o[i] = gelu_tanh(u[i]) * mx * siluf_(gt[i]); }
            *(u32x4*)(yrow + c) = pack8(o);
        }
    }
    __syncthreads();
}

__device__ __forceinline__ void conv_tile(const Params& p, int l, int tile, LAS unsigned char* lds) {
    const int tid = opaque_tid();
    const bf16_t* h = (const bf16_t*)(p.ws + WS_H);
    bf16_t* y = (bf16_t*)(p.ws + WS_Y);
    const long t0 = (long)tile * 64;
    const long bstart = (t0 / SEQ) * SEQ;
    LAS float* hg = (LAS float*)lds;
    for (int it = tid; it < 94 * 32; it += NTHR) {
        const int r = it >> 5, c8 = (it & 31) * 8;
        const long t = t0 - 30 + r;
        float o[8];
        if (t >= bstart) {
            float a[8], b[8];
            unpack8(*(const u32x4*)(h + (size_t)t * DIN + OFF_BV + c8), a);
            unpack8(*(const u32x4*)(h + (size_t)t * DIN + OFF_BGLU + c8), b);
#pragma unroll
            for (int i = 0; i < 8; ++i) o[i] = a[i] * sigmoidf_(b[i]);
        } else {
#pragma unroll
            for (int i = 0; i < 8; ++i) o[i] = 0.f;
        }
        *(LAS f32x4*)(hg + r * 256 + c8) = (f32x4){o[0], o[1], o[2], o[3]};
        *(LAS f32x4*)(hg + r * 256 + c8 + 4) = (f32x4){o[4], o[5], o[6], o[7]};
    }
    __syncthreads();
    const int c = tid & 255, seg = tid >> 8;
    float outv[32];
    {
        float w[31];
#pragma unroll
        for (int j = 0; j < 31; ++j) w[j] = p.conv_w[(l * 31 + j) * 256 + c];
        const float bias = p.conv_b[l * 256 + c];
#pragma unroll
        for (int g = 0; g < 4; ++g) {
            float in[38];
#pragma unroll
            for (int i = 0; i < 38; ++i) in[i] = hg[(seg * 32 + g * 8 + i) * 256 + c];
#pragma unroll
            for (int o = 0; o < 8; ++o) {
                float a = bias;
#pragma unroll
                for (int j = 0; j < 31; ++j) a += w[j] * in[o + j];
                outv[g * 8 + o] = a;
            }
        }
    }
    __syncthreads();
#pragma unroll
    for (int o = 0; o < 32; ++o) hg[(seg * 32 + o) * 256 + c] = outv[o];
    __syncthreads();
    {
        const int t = tid >> 3, sl = tid & 7;
        float v[32];
#pragma unroll
        for (int i = 0; i < 8; ++i) { const f32x4 q = *(const LAS f32x4*)(hg + t * 256 + sl * 32 + i * 4); v[i * 4] = q[0]; v[i * 4 + 1] = q[1]; v[i * 4 + 2] = q[2]; v[i * 4 + 3] = q[3]; }
        float s = 0.f;
#pragma unroll
        for (int i = 0; i < 32; ++i) s += v[i];
        s = xor_sum8(s); const float mean = s * (1.0f / 256.0f);
        float q = 0.f;
#pragma unroll
        for (int i = 0; i < 32; ++i) { const float d = v[i] - mean; q += d * d; }
        q = xor_sum8(q); const float rstd = rsqrtf(q * (1.0f / 256.0f) + LN_EPS);
        const bf16_t* hrow = h + (size_t)(t0 + t) * DIN + OFF_BG + sl * 32;
        bf16_t* yrow = y + (size_t)(t0 + t) * DM + 256 + sl * 32;
#pragma unroll
        for (int g = 0; g < 4; ++g) {
            float gt[8], o[8];
            unpack8(*(const u32x4*)(hrow + g * 8), gt);
#pragma unroll
            for (int i = 0; i < 8; ++i) {
                const int cc = sl * 32 + g * 8 + i;
                const float n = (v[g * 8 + i] - mean) * rstd * p.conv_ln_g[l * 256 + cc] + p.conv_ln_b[l * 256 + cc];
                o[i] = siluf_(n) * siluf_(gt[i]);
            }
            *(u32x4*)(yrow + g * 8) = pack8(o);
        }
    }
    __syncthreads();
}

namespace hg {
constexpr int QS = 136, TS = 72, OS = 132, SS = 136;
constexpr int O_S = 0;
constexpr int O_Q1 = O_S + 128 * SS * 2;
constexpr int O_K1 = O_Q1 + 64 * QS * 2;
constexpr int O_OB = O_Q1;
constexpr int O_Q2 = O_K1 + 64 * QS * 2;
constexpr int O_VT = O_Q2 + 64 * QS * 2;
constexpr int O_KT = O_VT + 128 * TS * 2;
constexpr int O_RAW = O_Q2;
constexpr int O_P = O_KT + 128 * TS * 2;
constexpr int O_TOT = O_P + 64 * TS * 2;
constexpr int O_DEC = O_TOT + 2048;
constexpr int O_END = O_DEC + 512;
static_assert(64 * OS * 4 <= 2 * 64 * QS * 2, "ob alias");
static_assert(3 * 16384 <= 64 * QS * 2 + 2 * 128 * TS * 2, "raw alias");
constexpr int P1_RAW = 0;
constexpr int P1_VT = 32768, P1_KT = P1_VT + 128 * TS * 2, P1_TOT = P1_KT + 128 * TS * 2, P1_DEC = P1_TOT + 2048;
}
__device__ __forceinline__ float lower_bound(const Params& p, int l, int ch) {
    if (l == 0) return 0.f;
    return frcp(1.0f + fexp(p.hgrn_lb[ch] - p.hgrn_lb[512 + ch]));
}
__device__ __forceinline__ float hgrn_gates16(const LAS bf16_t* rawf, int d, int s4, float lb, float (&bcum)[16], float (&kk)[16]) {
    float run = 0.f;
#pragma unroll
    for (int i = 0; i < 16; ++i) {
        float z = bf2f(rawf[(s4 * 16 + i) * 128 + d]);
        z = fmaxf(z, -60.f);
        const float e = fexp(-z), r = frcp(1.0f + e);
        const float f = lb + (1.0f - lb) * r;
        kk[i] = (1.0f - lb) * (e * r);
        run += __logf(f);
        bcum[i] = run;
    }
    return run;
}
__device__ __forceinline__ u32x4 pk8(const float* v) { u32x4 w; w.x = cvt_pk_bf16(v[0], v[1]); w.y = cvt_pk_bf16(v[2], v[3]); w.z = cvt_pk_bf16(v[4], v[5]); w.w = cvt_pk_bf16(v[6], v[7]); return w; }

__device__ __forceinline__ void hgrn_pass1(const Params& p, int l, int unit, LAS unsigned char* lds) {
    const int tid = opaque_tid(), lane = tid & 63, wid = tid >> 6;
    const int bh = unit >> 3, seg = unit & 7, b = bh >> 2, head = bh & 3;
    const bf16_t* hbase = (const bf16_t*)(p.ws + WS_H) + ((size_t)b * SEQ + (size_t)seg * 1024) * DIN + head * 128;
    LAS bf16_t* rawf = (LAS bf16_t*)(lds + hg::P1_RAW); LAS bf16_t* rawi = rawf + 8192;
    LAS bf16_t* vT = (LAS bf16_t*)(lds + hg::P1_VT); LAS bf16_t* kT = (LAS bf16_t*)(lds + hg::P1_KT);
    LAS float* tot = (LAS float*)(lds + hg::P1_TOT); LAS float* dec = (LAS float*)(lds + hg::P1_DEC);
    constexpr int TS = hg::TS;
    const int d = tid & 127, s4 = tid >> 7, fr = lane & 15, fq = lane >> 4, mb = wid >> 1, nh = wid & 1;
    const float lb = lower_bound(p, l, head * 128 + d);
    f32x4 accS[2][4];
#pragma unroll
    for (int m = 0; m < 2; ++m)
#pragma unroll
        for (int n = 0; n < 4; ++n) accS[m][n] = (f32x4){0.f, 0.f, 0.f, 0.f};
    float bsum = 0.f;
    u32x4 rf[2], ri[2];
    const int prow = tid >> 4, pcol = (tid & 15) * 8;
#pragma unroll
    for (int j = 0; j < 2; ++j) { const bf16_t* rp = hbase + (size_t)(prow + 32 * j) * DIN + pcol; rf[j] = *(const u32x4*)(rp + OFF_CF); ri[j] = *(const u32x4*)(rp + OFF_CI); }
    for (int c = 0; c < 16; ++c) {
#pragma unroll
        for (int j = 0; j < 2; ++j) { *(LAS u32x4*)(rawf + (prow + 32 * j) * 128 + pcol) = rf[j]; *(LAS u32x4*)(rawi + (prow + 32 * j) * 128 + pcol) = ri[j]; }
        __syncthreads();
        if (c + 1 < 16) {
#pragma unroll
            for (int j = 0; j < 2; ++j) { const bf16_t* rp = hbase + (size_t)((c + 1) * 64 + prow + 32 * j) * DIN + pcol; rf[j] = *(const u32x4*)(rp + OFF_CF); ri[j] = *(const u32x4*)(rp + OFF_CI); }
        }
        float bcum[16], kk[16];
        const float run = hgrn_gates16(rawf, d, s4, lb, bcum, kk);
        tot[s4 * 128 + d] = run;
        {
            float vv[16];
#pragma unroll
            for (int i = 0; i < 16; ++i) vv[i] = bf2f(rawi[(s4 * 16 + i) * 128 + d]);
            *(LAS u32x4*)(vT + d * TS + s4 * 16) = pk8(vv); *(LAS u32x4*)(vT + d * TS + s4 * 16 + 8) = pk8(vv + 8);
        }
        __syncthreads();
        const float t0 = tot[d], t1 = tot[128 + d], t2 = tot[256 + d], t3 = tot[384 + d];
        const float off = (s4 > 0 ? t0 : 0.f) + (s4 > 1 ? t1 : 0.f) + (s4 > 2 ? t2 : 0.f);
        const float blast = (t0 + t1) + (t2 + t3);
        {
            float kv[16];
#pragma unroll
            for (int i = 0; i < 16; ++i) kv[i] = kk[i] * fexp(blast - (bcum[i] + off));
            *(LAS u32x4*)(kT + d * TS + s4 * 16) = pk8(kv); *(LAS u32x4*)(kT + d * TS + s4 * 16 + 8) = pk8(kv + 8);
            if (s4 == 0) { dec[d] = fexp(blast); bsum += blast; }
        }
        __syncthreads();
#pragma unroll
        for (int m = 0; m < 2; ++m) {
            const f32x4 dc = *(const LAS f32x4*)(dec + mb * 32 + m * 16 + fq * 4);
#pragma unroll
            for (int n = 0; n < 4; ++n) accS[m][n] *= dc;
        }
#pragma unroll
        for (int k2 = 0; k2 < 2; ++k2) {
            bf16x8 a[2], bb[4];
#pragma unroll
            for (int m = 0; m < 2; ++m) a[m] = *(const LAS bf16x8*)(kT + (mb * 32 + m * 16 + fr) * TS + k2 * 32 + fq * 8);
#pragma unroll
            for (int n = 0; n < 4; ++n) bb[n] = *(const LAS bf16x8*)(vT + (nh * 64 + n * 16 + fr) * TS + k2 * 32 + fq * 8);
#pragma unroll
            for (int m = 0; m < 2; ++m)
#pragma unroll
                for (int n = 0; n < 4; ++n) accS[m][n] = __builtin_amdgcn_mfma_f32_16x16x32_bf16(a[m], bb[n], accS[m][n], 0, 0, 0);
        }
    }
    float* sds = (float*)(p.ws + WS_ST) + (size_t)unit * 16384;
#pragma unroll
    for (int m = 0; m < 2; ++m)
#pragma unroll
        for (int n = 0; n < 4; ++n) *(f32x4*)(sds + (nh * 64 + n * 16 + fr) * 128 + mb * 32 + m * 16 + fq * 4) = accS[m][n];
    if (s4 == 0) ((float*)(p.ws + WS_DEC))[(size_t)unit * 128 + d] = fexp(bsum);
    __syncthreads();
}

__device__ __forceinline__ void hgrn_pass2(const Params& p, int l, int unit, LAS unsigned char* lds) {
    const int tid = opaque_tid(), lane = tid & 63, wid = tid >> 6;
    const int bh = unit >> 3, seg = unit & 7, b = bh >> 2, head = bh & 3;
    const size_t tokb = (size_t)b * SEQ + (size_t)seg * 1024;
    const bf16_t* hbase = (const bf16_t*)(p.ws + WS_H) + tokb * DIN + head * 128;
    constexpr int QS = hg::QS, TS = hg::TS, OS = hg::OS, SS = hg::SS;
    LAS bf16_t* Sl = (LAS bf16_t*)(lds + hg::O_S);
    LAS bf16_t* q1 = (LAS bf16_t*)(lds + hg::O_Q1); LAS bf16_t* k1 = (LAS bf16_t*)(lds + hg::O_K1); LAS bf16_t* q2 = (LAS bf16_t*)(lds + hg::O_Q2);
    LAS bf16_t* vT = (LAS bf16_t*)(lds + hg::O_VT); LAS bf16_t* kT = (LAS bf16_t*)(lds + hg::O_KT); LAS bf16_t* P = (LAS bf16_t*)(lds + hg::O_P);
    LAS float* ob = (LAS float*)(lds + hg::O_OB); LAS float* tot = (LAS float*)(lds + hg::O_TOT); LAS float* dec = (LAS float*)(lds + hg::O_DEC);
    LAS bf16_t* rawq = (LAS bf16_t*)(lds + hg::O_RAW); LAS bf16_t* rawf = rawq + 8192; LAS bf16_t* rawi = rawf + 8192;
    const int d = tid & 127, s4 = tid >> 7, fr = lane & 15, fq = lane >> 4, mb = wid >> 1, nh = wid & 1;
    const float lb = lower_bound(p, l, head * 128 + d);
    f32x4 accS[2][4];
#pragma unroll
    for (int m = 0; m < 2; ++m)
#pragma unroll
        for (int n = 0; n < 4; ++n) accS[m][n] = (f32x4){0.f, 0.f, 0.f, 0.f};
    for (int i = 0; i < seg; ++i) {
        const float* sds = (const float*)(p.ws + WS_ST) + (size_t)(bh * 8 + i) * 16384;
        const float* sdd = (const float*)(p.ws + WS_DEC) + (size_t)(bh * 8 + i) * 128;
#pragma unroll
        for (int m = 0; m < 2; ++m) {
            const f32x4 dc = *(const f32x4*)(sdd + mb * 32 + m * 16 + fq * 4);
#pragma unroll
            for (int n = 0; n < 4; ++n) accS[m][n] = accS[m][n] * dc + *(const f32x4*)(sds + (nh * 64 + n * 16 + fr) * 128 + mb * 32 + m * 16 + fq * 4);
        }
    }
#pragma unroll
    for (int m = 0; m < 2; ++m)
#pragma unroll
        for (int n = 0; n < 4; ++n) { u32x2 w; w.x = cvt_pk_bf16(accS[m][n][0], accS[m][n][1]); w.y = cvt_pk_bf16(accS[m][n][2], accS[m][n][3]);
            *(LAS u32x2*)(Sl + (nh * 64 + n * 16 + fr) * SS + mb * 32 + m * 16 + fq * 4) = w; }
    u32x4 rq[2], rf[2], ri[2], rg[2];
    const int prow = tid >> 4, pcol = (tid & 15) * 8;
    const int et = tid >> 3, esl = tid & 7;
#pragma unroll
    for (int j = 0; j < 2; ++j) { const bf16_t* rp = hbase + (size_t)(prow + 32 * j) * DIN + pcol; rq[j] = *(const u32x4*)(rp + OFF_CQ); rf[j] = *(const u32x4*)(rp + OFF_CF); ri[j] = *(const u32x4*)(rp + OFF_CI); }
    for (int c = 0; c < 16; ++c) {
#pragma unroll
        for (int j = 0; j < 2; ++j) { const int o = (prow + 32 * j) * 128 + pcol; *(LAS u32x4*)(rawq + o) = rq[j]; *(LAS u32x4*)(rawf + o) = rf[j]; *(LAS u32x4*)(rawi + o) = ri[j]; }
        __syncthreads();
        if (c + 1 < 16) {
#pragma unroll
            for (int j = 0; j < 2; ++j) { const bf16_t* rp = hbase + (size_t)((c + 1) * 64 + prow + 32 * j) * DIN + pcol; rq[j] = *(const u32x4*)(rp + OFF_CQ); rf[j] = *(const u32x4*)(rp + OFF_CF); ri[j] = *(const u32x4*)(rp + OFF_CI); }
        }
#pragma unroll
        for (int j = 0; j < 2; ++j) rg[j] = *(const u32x4*)(hbase + (size_t)(c * 64 + et) * DIN + OFF_CG + esl * 16 + j * 8);
        float bcum[16], kk[16], sq[16];
        u32x4 vpk0, vpk1;
        const float run = hgrn_gates16(rawf, d, s4, lb, bcum, kk);
        tot[s4 * 128 + d] = run;
        {
            float vv[16];
#pragma unroll
            for (int i = 0; i < 16; ++i) { sq[i] = siluf_(bf2f(rawq[(s4 * 16 + i) * 128 + d])); vv[i] = bf2f(rawi[(s4 * 16 + i) * 128 + d]); }
            vpk0 = pk8(vv); vpk1 = pk8(vv + 8);
        }
        __syncthreads();
        const float t0 = tot[d], t1 = tot[128 + d], t2 = tot[256 + d], t3 = tot[384 + d];
        const float off = (s4 > 0 ? t0 : 0.f) + (s4 > 1 ? t1 : 0.f) + (s4 > 2 ? t2 : 0.f);
        const float bmid = t0 + t1, blast = (t0 + t1) + (t2 + t3);
        {
            const float cm = fexp(bmid), cl = fexp(blast - bmid);
            float kv[16];
#pragma unroll
            for (int i = 0; i < 16; ++i) {
                const int t = s4 * 16 + i;
                const float x = (bcum[i] + off) - bmid;
                const float e1 = fexp(fminf(fmaxf(x, -80.f), 80.f)), e2 = frcp(e1);
                const float qa = sq[i] * e1, qb = qa * cm, ka = kk[i] * e2;
                kv[i] = ka * cl;
                q1[t * QS + d] = (bf16_t)(cvt_pk_bf16(qa, 0.f) & 0xffffu);
                q2[t * QS + d] = (bf16_t)(cvt_pk_bf16(qb, 0.f) & 0xffffu);
                k1[t * QS + d] = (bf16_t)(cvt_pk_bf16(ka, 0.f) & 0xffffu);
            }
            *(LAS u32x4*)(kT + d * TS + s4 * 16) = pk8(kv); *(LAS u32x4*)(kT + d * TS + s4 * 16 + 8) = pk8(kv + 8);
            *(LAS u32x4*)(vT + d * TS + s4 * 16) = vpk0; *(LAS u32x4*)(vT + d * TS + s4 * 16 + 8) = vpk1;
            if (s4 == 0) dec[d] = fexp(blast);
        }
        __syncthreads();
#pragma unroll
        for (int sbi = 0; sbi < 2; ++sbi) {
            const int sb = nh * 2 + sbi;
            f32x4 sc = (f32x4){0.f, 0.f, 0.f, 0.f};
            if (sb <= mb) {
#pragma unroll
                for (int k4 = 0; k4 < 4; ++k4) {
                    const bf16x8 a = *(const LAS bf16x8*)(q1 + (mb * 16 + fr) * QS + k4 * 32 + fq * 8);
                    const bf16x8 bb = *(const LAS bf16x8*)(k1 + (sb * 16 + fr) * QS + k4 * 32 + fq * 8);
                    sc = __builtin_amdgcn_mfma_f32_16x16x32_bf16(a, bb, sc, 0, 0, 0);
                }
            }
#pragma unroll
            for (int j = 0; j < 4; ++j) {
                const int t = mb * 16 + fq * 4 + j, s = sb * 16 + fr;
                const float v = (sb <= mb && s <= t) ? sc[j] : 0.f;
                P[t * TS + s] = (bf16_t)(cvt_pk_bf16(v, 0.f) & 0xffffu);
            }
        }
        __syncthreads();
        f32x4 acc[4];
#pragma unroll
        for (int n = 0; n < 4; ++n) acc[n] = (f32x4){0.f, 0.f, 0.f, 0.f};
#pragma unroll
        for (int k2 = 0; k2 < 2; ++k2) {
            const bf16x8 a = *(const LAS bf16x8*)(P + (mb * 16 + fr) * TS + k2 * 32 + fq * 8);
#pragma unroll
            for (int n = 0; n < 4; ++n) {
                const bf16x8 bb = *(const LAS bf16x8*)(vT + (nh * 64 + n * 16 + fr) * TS + k2 * 32 + fq * 8);
                acc[n] = __builtin_amdgcn_mfma_f32_16x16x32_bf16(a, bb, acc[n], 0, 0, 0);
            }
        }
#pragma unroll
        for (int k4 = 0; k4 < 4; ++k4) {
            const bf16x8 a = *(const LAS bf16x8*)(q2 + (mb * 16 + fr) * QS + k4 * 32 + fq * 8);
#pragma unroll
            for (int n = 0; n < 4; ++n) {
                const bf16x8 bb = *(const LAS bf16x8*)(Sl + (nh * 64 + n * 16 + fr) * SS + k4 * 32 + fq * 8);
                acc[n] = __builtin_amdgcn_mfma_f32_16x16x32_bf16(a, bb, acc[n], 0, 0, 0);
            }
        }
        __syncthreads();
#pragma unroll
        for (int n = 0; n < 4; ++n)
#pragma unroll
            for (int j = 0; j < 4; ++j) ob[(mb * 16 + fq * 4 + j) * OS + nh * 64 + n * 16 + fr] = acc[n][j];
#pragma unroll
        for (int m = 0; m < 2; ++m) {
            const f32x4 dc = *(const LAS f32x4*)(dec + mb * 32 + m * 16 + fq * 4);
#pragma unroll
            for (int n = 0; n < 4; ++n) accS[m][n] *= dc;
        }
#pragma unroll
        for (int k2 = 0; k2 < 2; ++k2) {
            bf16x8 a[2], bb[4];
#pragma unroll
            for (int m = 0; m < 2; ++m) a[m] = *(const LAS bf16x8*)(kT + (mb * 32 + m * 16 + fr) * TS + k2 * 32 + fq * 8);
#pragma unroll
            for (int n = 0; n < 4; ++n) bb[n] = *(const LAS bf16x8*)(vT + (nh * 64 + n * 16 + fr) * TS + k2 * 32 + fq * 8);
#pragma unroll
            for (int m = 0; m < 2; ++m)
#pragma unroll
                for (int n = 0; n < 4; ++n) accS[m][n] = __builtin_amdgcn_mfma_f32_16x16x32_bf16(a[m], bb[n], accS[m][n], 0, 0, 0);
        }
#pragma unroll
        for (int m = 0; m < 2; ++m)
#pragma unroll
            for (int n = 0; n < 4; ++n) { u32x2 w; w.x = cvt_pk_bf16(accS[m][n][0], accS[m][n][1]); w.y = cvt_pk_bf16(accS[m][n][2], accS[m][n][3]);
                *(LAS u32x2*)(Sl + (nh * 64 + n * 16 + fr) * SS + mb * 32 + m * 16 + fq * 4) = w; }
        __syncthreads();
        {
            float v[16];
#pragma unroll
            for (int i = 0; i < 4; ++i) { const f32x4 q = *(const LAS f32x4*)(ob + et * OS + esl * 16 + i * 4); v[i * 4] = q[0]; v[i * 4 + 1] = q[1]; v[i * 4 + 2] = q[2]; v[i * 4 + 3] = q[3]; }
            float s = 0.f;
#pragma unroll
            for (int i = 0; i < 16; ++i) s += v[i] * v[i];
            s = xor_sum8(s);
            const float r = rsqrtf(s * (1.0f / 128.0f) + LN_EPS);
            bf16_t* yrow = (bf16_t*)(p.ws + WS_Y) + (tokb + (size_t)c * 64 + et) * DM + 512 + head * 128 + esl * 16;
            const float* ng = p.hgrn_norm_g + l * 512 + head * 128 + esl * 16;
#pragma unroll
            for (int g = 0; g < 2; ++g) {
                float gt[8], o[8];
                unpack8(rg[g], gt);
                const f32x4 n0 = *(const f32x4*)(ng + g * 8), n1 = *(const f32x4*)(ng + g * 8 + 4);
#pragma unroll
                for (int i = 0; i < 8; ++i) o[i] = v[g * 8 + i] * r * (i < 4 ? n0[i & 3] : n1[i & 3]) * siluf_(gt[i]);
                *(u32x4*)(yrow + g * 8) = pack8(o);
            }
        }
    }
    __syncthreads();
}


__device__ __forceinline__ void phase_ln(const Params& p, int l) {
    const int tid = opaque_tid(), lane = tid & 63, gw = blockIdx.x * (NTHR / 64) + (tid >> 6), nw = gridDim.x * (NTHR / 64);
    const float* z = (const float*)(p.ws + WS_Z);
    bf16_t* xb = (bf16_t*)(p.ws + WS_XB);
    const float* g = p.post_ln_g + l * DM; const float* bb = p.post_ln_b + l * DM;
    for (int row = gw; row < MTOK; row += nw) {
        f32x4 v[4];
#pragma unroll
        for (int i = 0; i < 4; ++i) v[i] = *(const f32x4*)(z + (size_t)row * DM + i * 256 + lane * 4);
        float s = 0.f;
#pragma unroll
        for (int i = 0; i < 4; ++i) s += v[i][0] + v[i][1] + v[i][2] + v[i][3];
#pragma unroll
        for (int o = 1; o < 64; o <<= 1) s += __shfl_xor(s, o);
        const float mean = s * (1.0f / 1024.0f);
        float q = 0.f;
#pragma unroll
        for (int i = 0; i < 4; ++i)
#pragma unroll
            for (int j = 0; j < 4; ++j) { const float d = v[i][j] - mean; q += d * d; }
#pragma unroll
        for (int o = 1; o < 64; o <<= 1) q += __shfl_xor(q, o);
        const float rstd = rsqrtf(q * (1.0f / 1024.0f) + LN_EPS);
#pragma unroll
        for (int i = 0; i < 4; ++i) {
            const int c = i * 256 + lane * 4;
            const f32x4 gg = *(const f32x4*)(g + c), b4 = *(const f32x4*)(bb + c);
            f32x4 o;
#pragma unroll
            for (int j = 0; j < 4; ++j) o[j] = (v[i][j] - mean) * rstd * gg[j] + b4[j];
            *(f32x4*)(p.out + (size_t)row * DM + c) = o;
            if (l == 0) { u32x2 w; w.x = cvt_pk_bf16(o[0], o[1]); w.y = cvt_pk_bf16(o[2], o[3]); *(u32x2*)(xb + (size_t)row * DM + c) = w; }
        }
    }
}

__global__ void __launch_bounds__(NTHR, 2) mega_fwd(Params p) {
    extern __shared__ __attribute__((aligned(16))) unsigned char lds_raw[];
    LAS unsigned char* lds = (LAS unsigned char*)lds_raw;
    cg::grid_group grid = cg::this_grid();
    for (int ph = p.ph_lo; ph < p.ph_hi; ++ph) {
        if (ph > p.ph_lo) grid.sync();
        if (ph == 0) { phase_prep(p); continue; }
        const int l = (ph - 1) / 5, sub = (ph - 1) % 5;
        if (sub == 0) {
            pg8::Gemm g{(const bf16_t*)(p.ws + WS_XB), (const bf16_t*)(p.ws + WS_WTIN) + (size_t)l * DIN * DM, MTOK, DIN, DM};
            pg8::StaticOrder S; S.init(MTOK, DIN, gridDim.x, blockIdx.x);
            pg8::EpiH E{(bf16_t*)(p.ws + WS_H), DIN};
            for (int rep = 0; rep < REP_G1; ++rep) pg8::gemm_phase(lds, g, S, E);
        } else if (sub == 1) {
            for (int rep = 0; rep < REP_M1A; ++rep) for (int u = blockIdx.x; u < 512; u += gridDim.x) sgu_chunk(p, l, u, lds);
            for (int rep = 0; rep < REP_M1B; ++rep) for (int u = blockIdx.x; u < 1024; u += gridDim.x) conv_tile(p, l, u, lds);
            for (int rep = 0; rep < REP_M1C; ++rep) for (int u = blockIdx.x; u < 256; u += gridDim.x) hgrn_pass1(p, l, u, lds);
        } else if (sub == 2) {
            for (int rep = 0; rep < REP_M3; ++rep) for (int u = blockIdx.x; u < 256; u += gridDim.x) hgrn_pass2(p, l, u, lds);
        } else if (sub == 3) {
            pg8::Gemm g{(const bf16_t*)(p.ws + WS_Y), (const bf16_t*)(p.ws + WS_WTOUT) + (size_t)l * DM * DM, MTOK, DM, DM};
            pg8::StaticOrder S; S.init(MTOK, DM, gridDim.x, blockIdx.x);
            pg8::EpiZ E{(float*)(p.ws + WS_Z), l == 0 ? p.x : p.out, DM};
            for (int rep = 0; rep < REP_G2; ++rep) pg8::gemm_phase(lds, g, S, E);
        } else {
            for (int rep = 0; rep < REP_LN; ++rep) phase_ln(p, l);
        }
    }
}

extern "C" void kernel_launch(void* const* d_in, const int* in_sizes, int n_in, void* d_out, int out_size, void* d_ws, size_t ws_size, hipStream_t stream) {
    static int grid_blocks = 0;
    if (!grid_blocks) {
        int dev = 0, cus = 0, per_cu = 0;
        hipGetDevice(&dev);
        hipDeviceGetAttribute(&cus, hipDeviceAttributeMultiprocessorCount, dev);
        hipFuncSetAttribute((const void*)mega_fwd, hipFuncAttributeMaxDynamicSharedMemorySize, LDS_BYTES);
        hipOccupancyMaxActiveBlocksPerMultiprocessor(&per_cu, (const void*)mega_fwd, NTHR, LDS_BYTES);
        if (per_cu < 1) { fprintf(stderr, "occupancy query returned %d\n", per_cu); per_cu = 1; }
        if (per_cu > 1) per_cu = 1;
        grid_blocks = cus * per_cu;
        if (ws_size < WS_END) fprintf(stderr, "workspace too small: %zu < %zu\n", ws_size, (size_t)WS_END);
    }
    Params p{};
    p.x = (const float*)d_in[0]; p.w_in = (const float*)d_in[1]; p.sgu_ln_g = (const float*)d_in[2]; p.sgu_ln_b = (const float*)d_in[3];
    p.sgu_w = (const float*)d_in[4]; p.sgu_b = (const float*)d_in[5]; p.conv_w = (const float*)d_in[6]; p.conv_b = (const float*)d_in[7];
    p.conv_ln_g = (const float*)d_in[8]; p.conv_ln_b = (const float*)d_in[9]; p.hgrn_lb = (const float*)d_in[10]; p.hgrn_norm_g = (const float*)d_in[11];
    p.w_out = (const float*)d_in[12]; p.post_ln_g = (const float*)d_in[13]; p.post_ln_b = (const float*)d_in[14];
    p.out = (float*)d_out; p.ws = (unsigned char*)d_ws;
    p.ph_lo = 0; p.ph_hi = 11;
    void* args[] = {&p};
    hipError_t e = hipLaunchCooperativeKernel((const void*)mega_fwd, dim3(grid_blocks), dim3(NTHR), args, LDS_BYTES, stream);
    if (e != hipSuccess) fprintf(stderr, "cooperative launch failed: %s (grid %d)\n", hipGetErrorString(e), grid_blocks);
}
```
